# Optimizing an MI355X kernel written in HIP

```python
import math
import jax
import jax.numpy as jnp
from jax import lax
import numpy as np

D_MODEL = 4096
BATCH = 1
SEQ = 8192
DEPTH = 4

GRID_W = 64
CTX_LEN = 256
N_MIXERS = 3
N_SSD_LAYERS = (DEPTH + 2) // 3
N_S5_LAYERS = (DEPTH + 1) // 3
N_DIFF_LAYERS = DEPTH // 3
RMS_EPS = 1e-6

FFN_DIM = D_MODEL
FFN_CONV = 3

SSD_D_INNER = 2 * D_MODEL
SSD_HEAD_DIM = 64
SSD_HEADS = SSD_D_INNER // SSD_HEAD_DIM
SSD_GROUPS = 8
SSD_HEADS_PER_GROUP = SSD_HEADS // SSD_GROUPS
SSD_STATE = 128
SSD_GN = SSD_GROUPS * SSD_STATE
SSD_CONV = 5
SSD_CONV_CH = SSD_D_INNER + 2 * SSD_GN
SSD_IN_COLS = 2 * SSD_D_INNER + 2 * SSD_GN + 2 * SSD_HEADS
SSD_CHUNK = 128

S5_GROUP_CH = 16
S5_GROUPS = D_MODEL // S5_GROUP_CH
S5_STATE = 64
S5_BLOCK_GROUPS = 32
S5_N_BLOCKS = S5_GROUPS // S5_BLOCK_GROUPS

ATT_HEAD_DIM = 128
ATT_HEADS = D_MODEL // (2 * ATT_HEAD_DIM)
ATT_SCALE = ATT_HEAD_DIM ** -0.5
ATT_Q_BLOCK = 128
ROPE_BASE = 10000.0

kernel_name = "hybrid_ssd_s5_diffattn_prefix_dit"


def rmsnorm(x, gain):
    xf = x.astype(jnp.float32)
    y = xf * lax.rsqrt(jnp.mean(xf * xf, axis=-1, keepdims=True) + RMS_EPS)
    return (y * gain.astype(jnp.float32)).astype(x.dtype)


def group_rmsnorm(y, gain, groups):
    shp = y.shape
    yg = y.astype(jnp.float32).reshape(*shp[:-1], groups, shp[-1] // groups)
    yg = yg * lax.rsqrt(jnp.mean(yg * yg, axis=-1, keepdims=True) + RMS_EPS)
    return yg.reshape(shp) * gain.astype(jnp.float32)


def modulate(h, shift, scale):
    return h * (1.0 + scale) + shift


def orient(t, reverse):
    return t[:, ::-1] if reverse else t


def dwconv_centred(u, w, b):
    k = w.shape[0]
    r = k // 2
    n = u.shape[1]
    up = jnp.pad(u, ((0, 0), (r, r), (0, 0)))
    out = b + up[:, 0:n] * w[0]
    for j in range(1, k):
        out = out + up[:, j:j + n] * w[j]
    return out


def conv_ffn(u, w_up, conv_w, conv_b, w_down):
    a = dwconv_centred(u @ w_up, conv_w, conv_b)
    gate, val = jnp.split(a, 2, axis=-1)
    return (jax.nn.silu(gate) * val) @ w_down


def ssd_chunked_scan(xs, dt, a, bm, cm, h0):
    f32 = jnp.float32
    bsz, n = xs.shape[:2]
    nc = n // SSD_CHUNK
    xs, bm, cm = xs.astype(f32), bm.astype(f32), cm.astype(f32)

    def chunks(t):
        return t.reshape(bsz, nc, SSD_CHUNK, *t.shape[2:])

    xdt = chunks(xs * dt[..., None])
    bc, cc = chunks(bm), chunks(cm)
    da = jnp.moveaxis(chunks(dt * a), 2, -1)
    cum = jnp.cumsum(da, axis=-1)
    lower = jnp.tril(jnp.ones((SSD_CHUNK, SSD_CHUNK), dtype=bool))
    decay_in = jnp.exp(jnp.where(lower, cum[..., :, None] - cum[..., None, :], -jnp.inf))
    cb = jnp.einsum('bclgn,bcsgn->bcgls', cc, bc)
    y_diag = jnp.einsum('bcgkls,bcsgkp->bclgkp', cb[:, :, :, None] * decay_in, xdt)
    decay_to_end = jnp.exp(cum[..., -1:] - cum)
    chunk_states = jnp.einsum('bclgn,bcgkl,bclgkp->bcgkpn', bc, decay_to_end, xdt)
    chunk_decay = jnp.exp(cum[..., -1])

    def carry_state(h, inp):
        s, d = inp
        return h * d[..., None, None] + s, h

    h_last, h_enter = lax.scan(carry_state, h0.astype(f32),
                               (jnp.moveaxis(chunk_states, 1, 0), jnp.moveaxis(chunk_decay, 1, 0)))
    h_enter = jnp.moveaxis(h_enter, 0, 1)
    y_off = jnp.einsum('bclgn,bcgkpn->bclgkp', cc, h_enter) * jnp.moveaxis(jnp.exp(cum), -1, 2)[..., None]
    y = (y_diag + y_off).reshape(bsz, n, *xs.shape[2:])
    return y, h_last


def ssd_mixer(u_lat, u_ctx, w_in, conv_w, conv_b, a_log, dt_bias, d_skip, norm_w, w_out, want_ctx):
    f32 = jnp.float32
    a = -jnp.exp(a_log.astype(f32)).reshape(2, SSD_GROUPS, SSD_HEADS_PER_GROUP)
    dt_b = dt_bias.astype(f32).reshape(2, SSD_GROUPS, SSD_HEADS_PER_GROUP)
    d_h = d_skip.astype(f32).reshape(SSD_GROUPS, SSD_HEADS_PER_GROUP, 1)

    def project(u):
        bsz, n, _ = u.shape
        zxbcdt = u @ w_in
        z = zxbcdt[..., :SSD_D_INNER]
        xbc = jax.nn.silu(dwconv_centred(zxbcdt[..., SSD_D_INNER:SSD_D_INNER + SSD_CONV_CH], conv_w, conv_b))
        xs = xbc[..., :SSD_D_INNER].reshape(bsz, n, SSD_GROUPS, SSD_HEADS_PER_GROUP, SSD_HEAD_DIM)
        bm = xbc[..., SSD_D_INNER:SSD_D_INNER + SSD_GN].reshape(bsz, n, SSD_GROUPS, SSD_STATE)
        cm = xbc[..., SSD_D_INNER + SSD_GN:].reshape(bsz, n, SSD_GROUPS, SSD_STATE)
        dt_raw = zxbcdt[..., SSD_D_INNER + SSD_CONV_CH:].reshape(bsz, n, 2, SSD_GROUPS, SSD_HEADS_PER_GROUP)
        dt = jax.nn.softplus(dt_raw.astype(f32) + dt_b)
        return z, xs, bm, cm, dt

    def scan_both(xs, bm, cm, dt, h0_f, h0_b):
        y_f, hf = ssd_chunked_scan(xs, dt[:, :, 0], a[0], bm, cm, h0_f)
        y_b, hb = ssd_chunked_scan(xs[:, ::-1], dt[:, ::-1, 1], a[1], bm[:, ::-1], cm[:, ::-1], h0_b)
        return y_f + y_b[:, ::-1] + d_h * xs.astype(f32), hf, hb

    def finish(y, z):
        bsz, n = z.shape[:2]
        y = y.reshape(bsz, n, SSD_D_INNER) * jax.nn.silu(z.astype(f32))
        y = group_rmsnorm(y, norm_w, SSD_GROUPS)
        return y.astype(z.dtype) @ w_out

    zc, xc, bc, cc, dtc = project(u_ctx)
    zl, xl, bl, cl, dtl = project(u_lat)
    h0 = jnp.zeros((u_lat.shape[0], SSD_GROUPS, SSD_HEADS_PER_GROUP, SSD_HEAD_DIM, SSD_STATE), f32)
    yc, st_f, st_b = scan_both(xc, bc, cc, dtc, h0, h0)
    yl, _, _ = scan_both(xl, bl, cl, dtl, st_f, st_b)
    out_l = finish(yl, zl)
    out_c = finish(yc, zc) if want_ctx else None
    return out_l, out_c


def complex_affine_combine(e1, e2):
    a1r, a1i, b1r, b1i = e1
    a2r, a2i, b2r, b2i = e2
    return (a2r * a1r - a2i * a1i,
            a2r * a1i + a2i * a1r,
            a2r * b1r - a2i * b1i + b2r,
            a2r * b1i + a2i * b1r + b2i)


def diag_ssm_scan(u, ar, ai, bbr, bbi, cr, ci, h0r, h0i):
    uf = u.astype(jnp.float32)
    bur = jnp.einsum('btgc,gpc->btgp', uf, bbr)
    bui = jnp.einsum('btgc,gpc->btgp', uf, bbi)
    bur = bur.at[:, 0].add(ar * h0r - ai * h0i)
    bui = bui.at[:, 0].add(ar * h0i + ai * h0r)
    shape = bur.shape
    _, _, sr, si = lax.associative_scan(
        complex_affine_combine,
        (jnp.broadcast_to(ar, shape), jnp.broadcast_to(ai, shape), bur, bui), axis=1)
    y = jnp.einsum('gcp,btgp->btgc', cr, sr) - jnp.einsum('gcp,btgp->btgc', ci, si)
    return y, sr[:, -1], si[:, -1]


def s5_mixer(u_lat, u_ctx, lam_re, lam_im, log_step, b_re, b_im, c_re, c_im, d_skip, glu_w, glu_b, want_ctx):
    f32 = jnp.float32
    step = jnp.exp(log_step.astype(f32))[..., None]
    lr, li = lam_re.astype(f32), lam_im.astype(f32)
    mag = jnp.exp(lr * step)
    ar, ai = mag * jnp.cos(li * step), mag * jnp.sin(li * step)
    den = lr * lr + li * li
    kr = ((ar - 1.0) * lr + ai * li) / den
    ki = (ai * lr - (ar - 1.0) * li) / den
    br, bi = b_re.astype(f32), b_im.astype(f32)
    bbr = kr[..., None] * br - ki[..., None] * bi
    bbi = kr[..., None] * bi + ki[..., None] * br
    cr, ci = c_re.astype(f32), c_im.astype(f32)

    def u_blocks(u):
        bsz, n, _ = u.shape
        return jnp.moveaxis(u.reshape(bsz, n, S5_N_BLOCKS, S5_BLOCK_GROUPS, S5_GROUP_CH), 2, 0)

    def p_blocks(p):
        return jnp.moveaxis(p.reshape(2, S5_N_BLOCKS, S5_BLOCK_GROUPS, *p.shape[2:]), 1, 0)

    def run_block(args):
        ul, uc, ar_b, ai_b, bbr_b, bbi_b, cr_b, ci_b = args
        zero = jnp.zeros((ul.shape[0], S5_BLOCK_GROUPS, S5_STATE), f32)
        ys_l, ys_c = [], []
        for d in range(2):
            rev = d == 1
            pars = (ar_b[d], ai_b[d], bbr_b[d], bbi_b[d], cr_b[d], ci_b[d])
            yc_d, sr, si = diag_ssm_scan(orient(uc, rev), *pars, zero, zero)
            yl_d, _, _ = diag_ssm_scan(orient(ul, rev), *pars, sr, si)
            ys_l.append(orient(yl_d, rev))
            ys_c.append(orient(yc_d, rev))
        return ys_l[0] + ys_l[1], ys_c[0] + ys_c[1]

    yl_b, yc_b = lax.map(run_block, (u_blocks(u_lat), u_blocks(u_ctx), p_blocks(ar), p_blocks(ai),
                                     p_blocks(bbr), p_blocks(bbi), p_blocks(cr), p_blocks(ci)))

    def finish(yb, u):
        bsz, n, _ = u.shape
        y = jnp.moveaxis(yb, 0, 2).reshape(bsz, n, D_MODEL) + d_skip.astype(f32) * u.astype(f32)
        y = jax.nn.gelu(y).astype(u.dtype)
        z = y @ glu_w + glu_b
        return (z[..., :D_MODEL] * jax.nn.sigmoid(z[..., D_MODEL:])).astype(u.dtype)

    out_l = finish(yl_b, u_lat)
    out_c = finish(yc_b, u_ctx) if want_ctx else None
    return out_l, out_c


def axial_rope_tables(n):
    f32 = jnp.float32
    rows = n // GRID_W
    row = jnp.repeat(jnp.arange(rows, dtype=f32), GRID_W)
    col = jnp.tile(jnp.arange(GRID_W, dtype=f32), rows)
    n_freq = ATT_HEAD_DIM // 4
    inv_freq = ROPE_BASE ** (-jnp.arange(n_freq, dtype=f32) / n_freq)
    ang_r = row[:, None] * inv_freq
    ang_c = col[:, None] * inv_freq
    return jnp.cos(ang_r), jnp.sin(ang_r), jnp.cos(ang_c), jnp.sin(ang_c)


def rotate_pairs(x, cos, sin):
    x1, x2 = jnp.split(x, 2, axis=-1)
    cos, sin = cos[None, :, None, :], sin[None, :, None, :]
    return jnp.concatenate([x1 * cos - x2 * sin, x1 * sin + x2 * cos], axis=-1)


def apply_axial_rope(x, cos_r, sin_r, cos_c, sin_c):
    xr, xc = jnp.split(x, 2, axis=-1)
    return jnp.concatenate([rotate_pairs(xr, cos_r, sin_r), rotate_pairs(xc, cos_c, sin_c)], axis=-1).astype(x.dtype)


def diff_softmax_attend(q, k, v, lam):
    bsz, nq = q.shape[:2]
    nk = k.shape[1]
    s = jnp.einsum('bqhd,bkhd->bhqk', q, k).astype(jnp.float32) * ATT_SCALE
    p = jax.nn.softmax(s, axis=-1).reshape(bsz, ATT_HEADS, 2, nq, nk)
    a = p[:, :, 0] - lam * p[:, :, 1]
    return jnp.einsum('bhqk,bkhe->bqhe', a, v.astype(jnp.float32))


def diff_attn_mixer(u_lat, u_ctx, w_q, w_k, w_v, w_o, q_gain, k_gain, lam_q1, lam_k1, lam_q2, lam_k2,
                    sub_gain, lambda_init, want_ctx):
    f32 = jnp.float32
    bsz, seq, _ = u_lat.shape

    def qkv(u):
        n = u.shape[1]
        q = rmsnorm((u @ w_q).reshape(bsz, n, 2 * ATT_HEADS, ATT_HEAD_DIM), q_gain)
        k = rmsnorm((u @ w_k).reshape(bsz, n, 2 * ATT_HEADS, ATT_HEAD_DIM), k_gain)
        v = (u @ w_v).reshape(bsz, n, ATT_HEADS, 2 * ATT_HEAD_DIM)
        return q, k, v

    ql, kl, vl = qkv(u_lat)
    qc, kc, vc = qkv(u_ctx)
    rope = axial_rope_tables(seq)
    ql, kl = apply_axial_rope(ql, *rope), apply_axial_rope(kl, *rope)
    lam = (jnp.exp(jnp.sum(lam_q1.astype(f32) * lam_k1.astype(f32)))
           - jnp.exp(jnp.sum(lam_q2.astype(f32) * lam_k2.astype(f32))) + lambda_init)

    k_all = jnp.concatenate([kc, kl], axis=1)
    v_all = jnp.concatenate([vc, vl], axis=1)
    nb = seq // ATT_Q_BLOCK
    q_blocks = jnp.moveaxis(ql.reshape(bsz, nb, ATT_Q_BLOCK, 2 * ATT_HEADS, ATT_HEAD_DIM), 1, 0)
    o_l = lax.map(lambda qb: diff_softmax_attend(qb, k_all, v_all, lam), q_blocks)
    o_l = jnp.moveaxis(o_l, 0, 1).reshape(bsz, seq, ATT_HEADS, 2 * ATT_HEAD_DIM)

    def finish(o):
        o = rmsnorm(o, sub_gain) * (1.0 - lambda_init)
        return o.reshape(bsz, o.shape[1], D_MODEL).astype(u_lat.dtype) @ w_o

    out_l = finish(o_l)
    out_c = finish(diff_softmax_attend(qc, kc, vc, lam)) if want_ctx else None
    return out_l, out_c


def setup_inputs(seed: int = 0) -> dict:
    key = jax.random.key(seed)
    keys = jax.random.split(key, 48)
    counter = [0]
    f32 = jnp.float32

    def nk():
        k = keys[counter[0]]
        counter[0] += 1
        return k

    def normal(shape, scale):
        return scale * jax.random.normal(nk(), shape, f32)

    def gain(shape):
        return 1.0 + 0.1 * jax.random.normal(nk(), shape, f32)

    def log_uniform(shape, lo, hi):
        return jax.random.uniform(nk(), shape, f32, math.log(lo), math.log(hi))

    D, F = D_MODEL, FFN_DIM
    inp = {}
    inp['x'] = normal((BATCH, SEQ, D), 1.0)
    inp['c'] = normal((BATCH, D), 1.0)
    inp['ctx'] = normal((BATCH, CTX_LEN, D), 1.0)
    inp['c_ctx'] = normal((D,), 1.0)
    inp['mod_w'] = normal((DEPTH, D, 6 * D), 0.5 * D ** -0.5)
    inp['mod_b'] = normal((DEPTH, 6 * D), 0.02)
    inp['norm_mix'] = gain((DEPTH, D))
    inp['norm_ffn'] = gain((DEPTH, D))
    inp['ffn_up'] = normal((DEPTH, D, 2 * F), D ** -0.5)
    inp['ffn_conv_w'] = normal((DEPTH, FFN_CONV, 2 * F), FFN_CONV ** -0.5)
    inp['ffn_conv_b'] = normal((DEPTH, 2 * F), 0.02)
    inp['ffn_down'] = normal((DEPTH, F, D), F ** -0.5)
    na = N_SSD_LAYERS
    inp['ssd_w_in'] = normal((na, D, SSD_IN_COLS), D ** -0.5)
    inp['ssd_conv_w'] = normal((na, SSD_CONV, SSD_CONV_CH), SSD_CONV ** -0.5)
    inp['ssd_conv_b'] = normal((na, SSD_CONV_CH), 0.02)
    inp['ssd_a_log'] = jnp.log(jax.random.uniform(nk(), (na, 2, SSD_HEADS), f32, 1.0, 16.0))
    dt0 = jnp.exp(log_uniform((na, 2, SSD_HEADS), 0.001, 0.1))
    inp['ssd_dt_bias'] = dt0 + jnp.log(-jnp.expm1(-dt0))
    inp['ssd_d'] = gain((na, SSD_HEADS))
    inp['ssd_norm'] = gain((na, SSD_D_INNER))
    inp['ssd_w_out'] = normal((na, SSD_D_INNER, D), SSD_D_INNER ** -0.5)
    nb = N_S5_LAYERS
    inp['s5_lam_re'] = -0.5 + normal((nb, 2, S5_GROUPS, S5_STATE), 0.01)
    inp['s5_lam_im'] = (jnp.broadcast_to(math.pi * jnp.arange(S5_STATE, dtype=f32), (nb, 2, S5_GROUPS, S5_STATE))
                        + normal((nb, 2, S5_GROUPS, S5_STATE), 0.01))
    inp['s5_log_step'] = log_uniform((nb, 2, S5_GROUPS), 0.001, 0.1)
    inp['s5_b_re'] = normal((nb, S5_GROUPS, S5_STATE, S5_GROUP_CH), (2 * S5_GROUP_CH) ** -0.5)
    inp['s5_b_im'] = normal((nb, S5_GROUPS, S5_STATE, S5_GROUP_CH), (2 * S5_GROUP_CH) ** -0.5)
    inp['s5_c_re'] = normal((nb, 2, S5_GROUPS, S5_GROUP_CH, S5_STATE), S5_STATE ** -0.5)
    inp['s5_c_im'] = normal((nb, 2, S5_GROUPS, S5_GROUP_CH, S5_STATE), S5_STATE ** -0.5)
    inp['s5_d'] = gain((nb, D))
    inp['s5_glu_w'] = normal((nb, D, 2 * D), D ** -0.5)
    inp['s5_glu_b'] = normal((nb, 2 * D), 0.02)
    nc = N_DIFF_LAYERS
    inp['da_w_q'] = normal((nc, D, D), D ** -0.5)
    inp['da_w_k'] = normal((nc, D, D), D ** -0.5)
    inp['da_w_v'] = normal((nc, D, D), D ** -0.5)
    inp['da_w_o'] = normal((nc, D, D), D ** -0.5)
    inp['da_q_norm'] = gain((nc, ATT_HEAD_DIM))
    inp['da_k_norm'] = gain((nc, ATT_HEAD_DIM))
    inp['da_lam_q1'] = normal((nc, ATT_HEAD_DIM), 0.1)
    inp['da_lam_k1'] = normal((nc, ATT_HEAD_DIM), 0.1)
    inp['da_lam_q2'] = normal((nc, ATT_HEAD_DIM), 0.1)
    inp['da_lam_k2'] = normal((nc, ATT_HEAD_DIM), 0.1)
    inp['da_sub_norm'] = gain((nc, 2 * ATT_HEAD_DIM))
    return inp


def reference(x, c, ctx, c_ctx, mod_w, mod_b, norm_mix, norm_ffn, ffn_up, ffn_conv_w, ffn_conv_b, ffn_down,
              ssd_w_in, ssd_conv_w, ssd_conv_b, ssd_a_log, ssd_dt_bias, ssd_d, ssd_norm, ssd_w_out,
              s5_lam_re, s5_lam_im, s5_log_step, s5_b_re, s5_b_im, s5_c_re, s5_c_im, s5_d, s5_glu_w, s5_glu_b,
              da_w_q, da_w_k, da_w_v, da_w_o, da_q_norm, da_k_norm, da_lam_q1, da_lam_k1, da_lam_q2, da_lam_k2,
              da_sub_norm):
    cond_lat = jax.nn.silu(c)
    cond_ctx = jax.nn.silu(c_ctx)
    for i in range(DEPTH):
        want_ctx = i < DEPTH - 1
        sh1, sc1, g1, sh2, sc2, g2 = jnp.split((cond_lat @ mod_w[i] + mod_b[i])[:, None, :], 6, axis=-1)
        csh1, csc1, cg1, csh2, csc2, cg2 = jnp.split((cond_ctx @ mod_w[i] + mod_b[i])[None, None, :], 6, axis=-1)
        h = modulate(rmsnorm(x, norm_mix[i]), sh1, sc1)
        hc = modulate(rmsnorm(ctx, norm_mix[i]), csh1, csc1)
        kind, j = i % N_MIXERS, i // N_MIXERS
        if kind == 0:
            o, oc = ssd_mixer(h, hc, ssd_w_in[j], ssd_conv_w[j], ssd_conv_b[j], ssd_a_log[j], ssd_dt_bias[j],
                              ssd_d[j], ssd_norm[j], ssd_w_out[j], want_ctx)
        elif kind == 1:
            o, oc = s5_mixer(h, hc, s5_lam_re[j], s5_lam_im[j], s5_log_step[j], s5_b_re[j], s5_b_im[j],
                             s5_c_re[j], s5_c_im[j], s5_d[j], s5_glu_w[j], s5_glu_b[j], want_ctx)
        else:
            lambda_init = 0.8 - 0.6 * math.exp(-0.3 * i)
            o, oc = diff_attn_mixer(h, hc, da_w_q[j], da_w_k[j], da_w_v[j], da_w_o[j], da_q_norm[j], da_k_norm[j],
                                    da_lam_q1[j], da_lam_k1[j], da_lam_q2[j], da_lam_k2[j], da_sub_norm[j],
                                    lambda_init, want_ctx)
        x = x + g1 * o
        hf = modulate(rmsnorm(x, norm_ffn[i]), sh2, sc2)
        x = x + g2 * conv_ffn(hf, ffn_up[i], ffn_conv_w[i], ffn_conv_b[i], ffn_down[i])
        if want_ctx:
            ctx = ctx + cg1 * oc
            hfc = modulate(rmsnorm(ctx, norm_ffn[i]), csh2, csc2)
            ctx = ctx + cg2 * conv_ffn(hfc, ffn_up[i], ffn_conv_w[i], ffn_conv_b[i], ffn_down[i])
    return x
```

```cpp
#include <hip/hip_runtime.h>
#include <cstdio>
#include <cstdint>
namespace pg8 {
#define PG8_LAS __attribute__((address_space(3)))
typedef unsigned short bf16_t;
typedef short bf16x8 __attribute__((ext_vector_type(8)));
typedef float f32x4 __attribute__((ext_vector_type(4)));
typedef unsigned u32x4 __attribute__((ext_vector_type(4)));
constexpr int BM = 256, BK = 64, HALF = 128, HTB = HALF * BK * 2  , STAGE_BYTES = 8 * HTB, NXCD = 8, WGM = 8;

__host__ __device__ __forceinline__ int lds_byte(int r, int c) { const int st = (r >> 4) * 2 + (c >> 5), rr = r & 15, cc = c & 31, ob = rr * 64 + cc * 2; return st * 1024 + (ob ^ (((ob >> 9) & 1) << 5)); }
__host__ __device__ __forceinline__ void stage_rc(int b, int& R, int& C) { const int st = b / 1024, sb = b % 1024, swz = sb ^ (((sb >> 9) & 1) << 5); R = (st >> 1) * 16 + swz / 64; C = (st & 1) * 32 + (swz % 64) / 2; }
__host__ __device__ __forceinline__ int perm32(int rho) { const int n = rho >> 4, i = rho & 15; return 8 * (i >> 2) + 4 * n + (i & 3); }

struct Unit { int pm, pn; };
struct Gemm { const bf16_t* A; const bf16_t* Bt; int M, N, K; };

struct StaticOrder {
    int nM, nN, nwg, G, c;
    __host__ __device__ void init(int M, int N, int G_, int c_) { nM = M / BM; nN = N / BM; nwg = nM * nN; G = G_; c = c_; }
    __host__ __device__ bool next(int i, Unit& u) const {
        const long L = (long)i * G + c; if (L >= nwg) return false;
        int wgid = (int)L; { const int q = nwg / NXCD, r = nwg % NXCD, xcd = wgid % NXCD, off = wgid / NXCD; wgid = (xcd < r ? xcd * (q + 1) : r * (q + 1) + (xcd - r) * q) + off; }
        const int nig = WGM * nN, gid = wgid / nig, fm = gid * WGM, gsz = (nM - fm) < WGM ? (nM - fm) : WGM;
        u.pm = fm + ((wgid % nig) % gsz); u.pn = (wgid % nig) / gsz; return true;
    }
    __device__ __forceinline__ void a_ready(const Unit&) const {}
    __device__ __forceinline__ void done(const Unit&) const {}
};

__device__ __forceinline__ unsigned cvt_pk_bf16(float lo, float hi) { unsigned r; asm volatile("v_cvt_pk_bf16_f32 %0, %1, %2" : "=v"(r) : "v"(lo), "v"(hi)); return r; }
typedef float f32x2 __attribute__((ext_vector_type(2)));
__device__ __forceinline__ float softplus_f(float x) { return fmaxf(x, 0.f) + __logf(1.f + __expf(-fabsf(x))); }
struct EpiStore {
    static constexpr bool PERM = true, AFTER_DRAIN = false;
    bf16_t* O; int ldc; const float* bias; int dt_pn; float* DT; const float* dtb; int row_off;
    __device__ __forceinline__ void operator()(const f32x4 (&acc)[2][2][4][2], const Unit& u, int wr, int wc, int fr, int fq) const {
        const int row0 = row_off + u.pm * BM + wr * 64 + fr; const int colt = u.pn * BM;
        if (u.pn == dt_pn) {
            const int lc0 = wc * 32 + 8 * fq;
#pragma unroll
            for (int ai = 0; ai < 2; ++ai)
#pragma unroll
                for (int m = 0; m < 4; ++m) { float* rowp = DT + (size_t)(row0 + ai * HALF + m * 16) * 256 + lc0;
#pragma unroll
                    for (int bj = 0; bj < 2; ++bj)
#pragma unroll
                        for (int n = 0; n < 2; ++n) { const f32x4 b = *(const f32x4*)(dtb + lc0 + bj * HALF + 4 * n); const f32x4 v = acc[ai][bj][m][n] + b;
                            f32x4 o; o[0] = softplus_f(v[0]); o[1] = softplus_f(v[1]); o[2] = softplus_f(v[2]); o[3] = softplus_f(v[3]);
                            *(f32x4*)(rowp + bj * HALF + 4 * n) = o; } }
            return;
        }
        const int col0 = colt + wc * 32 + 8 * fq;
        f32x4 bv[2][2];
#pragma unroll
        for (int bj = 0; bj < 2; ++bj)
#pragma unroll
            for (int n = 0; n < 2; ++n) bv[bj][n] = bias ? *(const f32x4*)(bias + col0 + bj * HALF + 4 * n) : (f32x4){0.f, 0.f, 0.f, 0.f};
#pragma unroll
        for (int ai = 0; ai < 2; ++ai)
#pragma unroll
            for (int m = 0; m < 4; ++m) { bf16_t* rowp = O + (size_t)(row0 + ai * HALF + m * 16) * ldc + col0;
#pragma unroll
                for (int bj = 0; bj < 2; ++bj) { const f32x4 v0 = acc[ai][bj][m][0] + bv[bj][0], v1 = acc[ai][bj][m][1] + bv[bj][1];
                    u32x4 w; w.x = cvt_pk_bf16(v0[0], v0[1]); w.y = cvt_pk_bf16(v0[2], v0[3]); w.z = cvt_pk_bf16(v1[0], v1[1]); w.w = cvt_pk_bf16(v1[2], v1[3]);
                    *(u32x4*)(rowp + bj * HALF) = w; } }
    }
};
typedef unsigned u32x2r __attribute__((ext_vector_type(2)));
struct EpiResid {
    static constexpr bool PERM = true, AFTER_DRAIN = false;
    bf16_t* X; const float* gate_lat; const float* gate_ctx; float* out; int row_off; const float* Xrd;
    __device__ __forceinline__ void operator()(const f32x4 (&acc)[2][2][4][2], const Unit& u, int wr, int wc, int fr, int fq) const {
        const int row0 = row_off + u.pm * BM + wr * 64 + fr, col0 = u.pn * BM + wc * 32 + 8 * fq;
        const float* gate = (row_off + u.pm * BM < 256) ? gate_ctx : gate_lat;
        f32x4 gv[2][2];
#pragma unroll
        for (int bj = 0; bj < 2; ++bj)
#pragma unroll
            for (int n = 0; n < 2; ++n) gv[bj][n] = *(const f32x4*)(gate + col0 + bj * HALF + 4 * n);
#pragma unroll
        for (int ai = 0; ai < 2; ++ai) {
            f32x4 xv[4][2][2];
            if (Xrd != nullptr) {
#pragma unroll
                for (int m = 0; m < 4; ++m) { const float* rowp = Xrd + (size_t)(row0 + ai * HALF + m * 16) * 4096 + col0;
#pragma unroll
                    for (int bj = 0; bj < 2; ++bj)
#pragma unroll
                        for (int n = 0; n < 2; ++n) xv[m][bj][n] = *(const f32x4*)(rowp + bj * HALF + 4 * n); }
            } else {
                u32x4 xb[4][2];
#pragma unroll
                for (int m = 0; m < 4; ++m) { const bf16_t* rowp = X + (size_t)(row0 + ai * HALF + m * 16) * 4096 + col0;
#pragma unroll
                    for (int bj = 0; bj < 2; ++bj) xb[m][bj] = *(const u32x4*)(rowp + bj * HALF); }
                asm volatile("" ::: "memory");
#pragma unroll
                for (int m = 0; m < 4; ++m)
#pragma unroll
                    for (int bj = 0; bj < 2; ++bj) { const unsigned w0 = xb[m][bj].x, w1 = xb[m][bj].y, w2 = xb[m][bj].z, w3 = xb[m][bj].w;
                        xv[m][bj][0] = f32x4{__builtin_bit_cast(float, w0 << 16), __builtin_bit_cast(float, w0 & 0xffff0000u), __builtin_bit_cast(float, w1 << 16), __builtin_bit_cast(float, w1 & 0xffff0000u)};
                        xv[m][bj][1] = f32x4{__builtin_bit_cast(float, w2 << 16), __builtin_bit_cast(float, w2 & 0xffff0000u), __builtin_bit_cast(float, w3 << 16), __builtin_bit_cast(float, w3 & 0xffff0000u)}; }
            }
            asm volatile("" ::: "memory");
#pragma unroll
            for (int m = 0; m < 4; ++m) { const int r = row0 + ai * HALF + m * 16;
#pragma unroll
                for (int bj = 0; bj < 2; ++bj) { const f32x4 o0 = xv[m][bj][0] + gv[bj][0] * acc[ai][bj][m][0], o1 = xv[m][bj][1] + gv[bj][1] * acc[ai][bj][m][1];
                    if (out != nullptr) { float* op = out + (size_t)(r - 256) * 4096 + col0 + bj * HALF; *(f32x4*)op = o0; *(f32x4*)(op + 4) = o1; }
                    else { u32x4 w; w.x = cvt_pk_bf16(o0.x, o0.y); w.y = cvt_pk_bf16(o0.z, o0.w); w.z = cvt_pk_bf16(o1.x, o1.y); w.w = cvt_pk_bf16(o1.z, o1.w); *(u32x4*)(X + (size_t)r * 4096 + col0 + bj * HALF) = w; } } }
            asm volatile("" ::: "memory");
        }
    }
};
template <class Epi, class Sched, bool ALIGN_EPI = false, bool SP2 = false>
__device__ __forceinline__ void gemm_phase(PG8_LAS unsigned char* lds, const Gemm g, const Sched& S, const Epi& E) {
    const int tid = threadIdx.x, wid = __builtin_amdgcn_readfirstlane(tid >> 6), lane = tid & 63, wr = wid >> 2, wc = wid & 3, fr = lane & 15, fq = lane >> 4;
    const int K = g.K, nt = K / BK;
    unsigned voffA[2], voffB[2];
#pragma unroll
    for (int i = 0; i < 2; ++i) { int R, C; stage_rc(tid * 16 + i * 8192, R, C); const int Rb = Epi::PERM ? ((R & ~31) + perm32(R & 31)) : R;
        voffA[i] = (unsigned)(R * K + C) * 2u; voffB[i] = (unsigned)(Rb * K + C) * 2u; }
    const size_t kstep = (size_t)(BK * 2);
    const size_t hstep = (size_t)HALF * K * 2;
    const size_t tstep = 2 * hstep;
    const unsigned ldsw = (unsigned)wid * 1024u;
    const int aoff = lds_byte(wr * 64 + fr, fq * 8), boff = lds_byte(wc * 32 + fr, fq * 8);
#define PG8_SA(b, h) (((b) * 2 + (h)) * HTB)
#define PG8_SB(b, h) ((4 + (b) * 2 + (h)) * HTB)
#define PG8_STAGE(bufoff, gbase, voff) do { _Pragma("unroll") for (int _i = 0; _i < 2; ++_i) \
        __builtin_amdgcn_global_load_lds((const unsigned*)((const char*)(gbase) + (voff)[_i]), (PG8_LAS unsigned*)(lds + (bufoff) + ldsw + _i * 8192), 16, 0, 0); } while (0)
#define PG8_LDA(dst, b, h) do { _Pragma("unroll") for (int m = 0; m < 4; ++m) _Pragma("unroll") for (int k = 0; k < 2; ++k) dst[m][k] = *(const PG8_LAS bf16x8*)(lds + PG8_SA(b, h) + aoff + m * 2048 + k * 1024); } while (0)
#define PG8_LDB(dst, b, h) do { _Pragma("unroll") for (int n = 0; n < 2; ++n) _Pragma("unroll") for (int k = 0; k < 2; ++k) dst[n][k] = *(const PG8_LAS bf16x8*)(lds + PG8_SB(b, h) + boff + n * 2048 + k * 1024); } while (0)
#define PG8_MMA(ai, bj, At, Bt) do { __builtin_amdgcn_s_setprio(1); _Pragma("unroll") for (int m = 0; m < 4; ++m) _Pragma("unroll") for (int n = 0; n < 2; ++n) _Pragma("unroll") for (int k = 0; k < 2; ++k) \
        acc[ai][bj][m][n] = __builtin_amdgcn_mfma_f32_16x16x32_bf16(Bt[n][k], At[m][k], acc[ai][bj][m][n], 0, 0, 0); __builtin_amdgcn_s_setprio(0); } while (0)
#define PG8_WAIT_V(n) asm volatile("s_waitcnt vmcnt(" #n ")" ::: "memory")
#define PG8_WAIT_L(n) asm volatile("s_waitcnt lgkmcnt(" #n ")" ::: "memory")
#define PG8_BAR __builtin_amdgcn_s_barrier()
#define PG8_SCHED __builtin_amdgcn_sched_barrier(0)
    Unit cur, nxt; int ui = 0;
    if (!S.next(0, cur)) return;
    f32x4 acc[2][2][4][2];
#pragma unroll
    for (int a = 0; a < 2; ++a)
#pragma unroll
        for (int b = 0; b < 2; ++b)
#pragma unroll
            for (int m = 0; m < 4; ++m)
#pragma unroll
                for (int n = 0; n < 2; ++n) acc[a][b][m][n] = (f32x4){0.f, 0.f, 0.f, 0.f};
    bf16x8 At[4][2], B0[2][2], B1[2][2];
    const char* cA = (const char*)g.A + (size_t)cur.pm * tstep; const char* cB = (const char*)g.Bt + (size_t)cur.pn * tstep;
    S.a_ready(cur);
    if constexpr (SP2) {
        PG8_STAGE(PG8_SB(0, 0), cB, voffB); PG8_STAGE(PG8_SB(0, 1), cB + hstep, voffB); PG8_STAGE(PG8_SA(0, 0), cA, voffA); PG8_STAGE(PG8_SA(0, 1), cA + hstep, voffA);
        if (wr == 1) PG8_BAR;
        PG8_WAIT_V(2); PG8_BAR;
        PG8_STAGE(PG8_SB(1, 0), cB + kstep, voffB); PG8_STAGE(PG8_SA(1, 0), cA + kstep, voffA); PG8_STAGE(PG8_SB(1, 1), cB + hstep + kstep, voffB);
        PG8_WAIT_V(6); PG8_BAR;
    } else {
        PG8_STAGE(PG8_SB(0, 0), cB, voffB); PG8_STAGE(PG8_SA(0, 0), cA, voffA); PG8_STAGE(PG8_SB(0, 1), cB + hstep, voffB); PG8_STAGE(PG8_SA(0, 1), cA + hstep, voffA);
        if (wr == 1) PG8_BAR;
        PG8_WAIT_V(4); PG8_BAR;
        PG8_STAGE(PG8_SB(1, 0), cB + kstep, voffB); PG8_STAGE(PG8_SA(1, 0), cA + kstep, voffA); PG8_STAGE(PG8_SB(1, 1), cB + hstep + kstep, voffB);
        PG8_WAIT_V(6); PG8_BAR;
    }
    for (;;) {
        const bool has_next = S.next(ui + 1, nxt);
        const char* nA = has_next ? (const char*)g.A + (size_t)nxt.pm * tstep : cA; const char* nB = has_next ? (const char*)g.Bt + (size_t)nxt.pn * tstep : cB;
        for (int t = 0; t < nt; t += 2) {
            const bool last = (t == nt - 2);
            const char* a1 = cA + (size_t)(t + 1) * kstep;
            const char* a2 = last ? nA : cA + (size_t)(t + 2) * kstep; const char* b2 = last ? nB : cB + (size_t)(t + 2) * kstep;
            const char* a3 = a2 + kstep; const char* b3 = b2 + kstep;
            if (last && has_next) S.a_ready(nxt);
            if constexpr (SP2) {
            PG8_LDB(B0, 0, 0); PG8_LDB(B1, 0, 1); PG8_SCHED; PG8_LDA(At, 0, 0); PG8_STAGE(PG8_SA(1, 1), a1 + hstep, voffA);
            PG8_WAIT_V(8); PG8_WAIT_L(0); PG8_BAR; PG8_MMA(0, 0, At, B0); PG8_MMA(0, 1, At, B1); PG8_BAR; PG8_SCHED;
            PG8_LDA(At, 0, 1); PG8_STAGE(PG8_SB(0, 0), b2, voffB); PG8_STAGE(PG8_SB(0, 1), b2 + hstep, voffB); PG8_STAGE(PG8_SA(0, 0), a2, voffA);
            PG8_WAIT_V(8); PG8_WAIT_L(0); PG8_BAR; PG8_MMA(1, 0, At, B0); PG8_MMA(1, 1, At, B1); PG8_BAR; PG8_SCHED;
            PG8_LDB(B0, 1, 0); PG8_LDB(B1, 1, 1); PG8_SCHED; PG8_LDA(At, 1, 0); PG8_STAGE(PG8_SA(0, 1), a2 + hstep, voffA);
            PG8_WAIT_V(8); PG8_WAIT_L(0); PG8_BAR; PG8_MMA(0, 0, At, B0); PG8_MMA(0, 1, At, B1); PG8_BAR; PG8_SCHED;
            PG8_LDA(At, 1, 1); PG8_STAGE(PG8_SB(1, 0), b3, voffB); PG8_STAGE(PG8_SB(1, 1), b3 + hstep, voffB); PG8_STAGE(PG8_SA(1, 0), a3, voffA);
            PG8_WAIT_V(8); PG8_WAIT_L(0); PG8_BAR; PG8_MMA(1, 0, At, B0); PG8_MMA(1, 1, At, B1); PG8_BAR; PG8_SCHED;
            } else {
            PG8_LDB(B0, 0, 0); PG8_SCHED; PG8_LDA(At, 0, 0); PG8_STAGE(PG8_SA(1, 1), a1 + hstep, voffA);
            PG8_WAIT_L(8); PG8_BAR; PG8_WAIT_L(0); PG8_MMA(0, 0, At, B0); PG8_BAR; PG8_SCHED;
            PG8_LDB(B1, 0, 1); PG8_STAGE(PG8_SB(0, 0), b2, voffB);
            PG8_BAR; PG8_WAIT_L(0); PG8_MMA(0, 1, At, B1); PG8_BAR;
            PG8_LDA(At, 0, 1); PG8_STAGE(PG8_SA(0, 0), a2, voffA);
            PG8_BAR; PG8_WAIT_L(0); PG8_MMA(1, 0, At, B0); PG8_BAR; PG8_SCHED;
            PG8_STAGE(PG8_SB(0, 1), b2 + hstep, voffB);
            PG8_WAIT_V(6); PG8_BAR; PG8_MMA(1, 1, At, B1); PG8_BAR;
            PG8_LDB(B0, 1, 0); PG8_SCHED; PG8_LDA(At, 1, 0); PG8_STAGE(PG8_SA(0, 1), a2 + hstep, voffA);
            PG8_WAIT_L(8); PG8_BAR; PG8_WAIT_L(0); PG8_MMA(0, 0, At, B0); PG8_BAR; PG8_SCHED;
            PG8_LDB(B1, 1, 1); PG8_STAGE(PG8_SB(1, 0), b3, voffB);
            PG8_BAR; PG8_WAIT_L(0); PG8_MMA(0, 1, At, B1); PG8_BAR;
            PG8_LDA(At, 1, 1); PG8_STAGE(PG8_SA(1, 0), a3, voffA);
            PG8_BAR; PG8_WAIT_L(0); PG8_MMA(1, 0, At, B0); PG8_BAR; PG8_SCHED;
            PG8_STAGE(PG8_SB(1, 1), b3 + hstep, voffB);
            PG8_WAIT_V(6); PG8_BAR; PG8_MMA(1, 1, At, B1); PG8_BAR;
            }
        }
        if constexpr (ALIGN_EPI) { if (wr == 0) PG8_BAR; }
        if constexpr (!Epi::AFTER_DRAIN) { E(acc, cur, wr, wc, fr, fq); S.done(cur); }
        if (!has_next) break;
#pragma unroll
        for (int a = 0; a < 2; ++a)
#pragma unroll
            for (int b = 0; b < 2; ++b)
#pragma unroll
                for (int m = 0; m < 4; ++m)
#pragma unroll
                    for (int n = 0; n < 2; ++n) acc[a][b][m][n] = (f32x4){0.f, 0.f, 0.f, 0.f};
        cur = nxt; cA = nA; cB = nB; ++ui;
        if constexpr (ALIGN_EPI) { if (wr == 1) PG8_BAR; }
    }
    PG8_WAIT_V(0);
    if constexpr (!ALIGN_EPI) { if (wr == 0) PG8_BAR; }
    PG8_BAR;
    if constexpr (Epi::AFTER_DRAIN) { E.fused(acc, cur, wr, wc, fr, fq, lds, wid, lane); S.done(cur); }
#undef PG8_SA
#undef PG8_SB
#undef PG8_STAGE
#undef PG8_LDA
#undef PG8_LDB
#undef PG8_MMA
#undef PG8_WAIT_V
#undef PG8_WAIT_L
#undef PG8_BAR
#undef PG8_SCHED
}
}
namespace att {
using bf16 = unsigned short;
constexpr int   D = 128, NW = 8, QBLK = 32, KVBLK = 64;
constexpr float SCALE = 0.088388347648318440f;
constexpr float THR = 8.f;
constexpr int SDEPTH = 2;
constexpr int LDQ = 12288, LDK = 12288, LDO = 8192;
constexpr size_t SHM_V = KVBLK * D * 2, SHM_K = KVBLK * D * 2, SHM_ATTN = 2 * SHM_V + 2 * SHM_K + NW * 64 * 4;
using bf16x8 = __attribute__((ext_vector_type(8))) short;
using s16x4  = __attribute__((ext_vector_type(4))) short;
using f32x16 = __attribute__((ext_vector_type(16))) float;
using f32x8  = __attribute__((ext_vector_type(8))) float;
using u32x4  = __attribute__((ext_vector_type(4))) unsigned;
#define KSWZ(row, colB) ((row) * 256 + ((colB) ^ (((row) & 7) << 4)))
#define SBAR() __builtin_amdgcn_sched_barrier(0)
__device__ __forceinline__ int crow(int r, int hi) { return (r & 3) + 8 * (r >> 2) + 4 * hi; }
__device__ __forceinline__ unsigned cvtpk(float lo, float hi) {
  unsigned r; asm volatile("v_cvt_pk_bf16_f32 %0, %1, %2" : "=v"(r) : "v"(lo), "v"(hi)); return r;
}
template <typename TIn> struct Stage;
template <> struct Stage<bf16>  { using T = bf16x8;
  __device__ static __forceinline__ T ld8(const bf16* p) { return *reinterpret_cast<const bf16x8*>(p); }
  __device__ static __forceinline__ bf16x8 tobf(T x) { return x; } };
template <> struct Stage<float> { using T = f32x8;
  __device__ static __forceinline__ T ld8(const float* p) { return *reinterpret_cast<const f32x8*>(p); }
  __device__ static __forceinline__ bf16x8 tobf(T x) {
    u32x4 w = {cvtpk(x[0], x[1]), cvtpk(x[2], x[3]), cvtpk(x[4], x[5]), cvtpk(x[6], x[7])}; return *reinterpret_cast<bf16x8*>(&w); } };

__device__ __forceinline__ void partialSM(f32x16& p0, f32x16& p1, float& m_reg, float& mn, float& alpha) {
  constexpr float C = SCALE * 1.4426950408889634f;
  float pmax = p0[0]; for (int r = 1; r < 16; ++r) pmax = fmaxf(pmax, p0[r]); for (int r = 0; r < 16; ++r) pmax = fmaxf(pmax, p1[r]);
  { auto rr = __builtin_amdgcn_permlane32_swap(__float_as_uint(pmax), __float_as_uint(pmax), false, false);
    pmax = fmaxf(__uint_as_float(rr[0]), __uint_as_float(rr[1])); }
  if (__builtin_expect(__all(pmax - m_reg <= THR / SCALE), 1)) { mn = m_reg; alpha = 1.f; }
  else { mn = fmaxf(m_reg, pmax); alpha = __builtin_amdgcn_exp2f((m_reg - mn) * C); m_reg = mn; }
  float mnC = -mn * C;
  for (int r = 0; r < 16; ++r) p0[r] = fmaf(p0[r], C, mnC); for (int r = 0; r < 16; ++r) p1[r] = fmaf(p1[r], C, mnC);
  for (int r = 0; r < 16; ++r) p0[r] = __builtin_amdgcn_exp2f(p0[r]);
}
__device__ __forceinline__ void finishSM(f32x16& p0, f32x16& p1, float alpha, float& l_reg, bf16x8& pa0, bf16x8& pa1, bf16x8& pa2, bf16x8& pa3) {
  for (int r = 0; r < 16; ++r) p1[r] = __builtin_amdgcn_exp2f(p1[r]);
  float ps = 0; for (int r = 0; r < 16; ++r) ps += p0[r]; for (int r = 0; r < 16; ++r) ps += p1[r];
  { auto rr = __builtin_amdgcn_permlane32_swap(__float_as_uint(ps), __float_as_uint(ps), false, false);
    ps = __uint_as_float(rr[0]) + __uint_as_float(rr[1]); }
  l_reg = l_reg * alpha + ps;
#define PK4(P, BASE, OUT) do { unsigned a0 = cvtpk(P[BASE + 0], P[BASE + 1]), a1 = cvtpk(P[BASE + 2], P[BASE + 3]);   \
    unsigned b0 = cvtpk(P[BASE + 4], P[BASE + 5]), b1 = cvtpk(P[BASE + 6], P[BASE + 7]);                              \
    auto r0 = __builtin_amdgcn_permlane32_swap(a0, b0, false, false); auto r1 = __builtin_amdgcn_permlane32_swap(a1, b1, false, false); \
    u32x4 w = {r0[0], r1[0], r0[1], r1[1]}; OUT = *reinterpret_cast<bf16x8*>(&w); } while (0)
  PK4(p0, 0, pa0); PK4(p0, 8, pa1); PK4(p1, 0, pa2); PK4(p1, 8, pa3);
#undef PK4
}
__device__ __forceinline__ void qkt(f32x16& p0, f32x16& p1, const bf16* Ks, const bf16x8* qr, int r32, int hi) {
  p0 = f32x16{}; p1 = f32x16{};
  for (int d0 = 0; d0 < 8; ++d0) { int cb = (d0 * 16 + hi * 8) * 2;
    bf16x8 b0 = *reinterpret_cast<const bf16x8*>((const char*)Ks + KSWZ(r32, cb));
    bf16x8 b1 = *reinterpret_cast<const bf16x8*>((const char*)Ks + KSWZ(32 + r32, cb));
    p0 = __builtin_amdgcn_mfma_f32_32x32x16_bf16(b0, qr[d0], p0, 0, 0, 0);
    p1 = __builtin_amdgcn_mfma_f32_32x32x16_bf16(b1, qr[d0], p1, 0, 0, 0); }
}
__device__ __forceinline__ int v_st(int k, int c) { const int kk = (k & ~0xC) | ((k & 4) << 1) | ((k & 8) >> 1); return ((kk >> 3) * 4 + (c >> 5)) * 512 + ((kk & 7) * 32 + (c & 31)) * 2; }
__device__ __forceinline__ int v_rd_base(int lane) { return ((lane & 3) << 3) | (((lane >> 2) & 3) << 6) | (((lane >> 4) & 1) << 5) | (((lane >> 5) & 1) << 8); }
constexpr int v_rd_off(int d0, int ks, int half) { return d0 * 512 + ks * 4096 + half * 2048; }
template <int OFF> __device__ __forceinline__ s16x4 tr_read(int vb) {
  s16x4 r; asm volatile("ds_read_b64_tr_b16 %0, %1 offset:%2" : "=&v"(r) : "v"(vb), "i"(OFF) : "memory"); return r;
}
template <int D0> __device__ __forceinline__ void pv_one(f32x16& od, int vb, bf16x8 pa0, bf16x8 pa1, bf16x8 pa2, bf16x8 pa3) {
  const s16x4 l0 = tr_read<v_rd_off(D0, 0, 0)>(vb), h0 = tr_read<v_rd_off(D0, 0, 1)>(vb), l1 = tr_read<v_rd_off(D0, 1, 0)>(vb), h1 = tr_read<v_rd_off(D0, 1, 1)>(vb);
  const s16x4 l2 = tr_read<v_rd_off(D0, 2, 0)>(vb), h2 = tr_read<v_rd_off(D0, 2, 1)>(vb), l3 = tr_read<v_rd_off(D0, 3, 0)>(vb), h3 = tr_read<v_rd_off(D0, 3, 1)>(vb);
  asm volatile("s_waitcnt lgkmcnt(0)" ::: "memory"); SBAR();
#define PK(L, H) (bf16x8){L[0], L[1], L[2], L[3], H[0], H[1], H[2], H[3]}
  od = __builtin_amdgcn_mfma_f32_32x32x16_bf16(pa0, PK(l0, h0), od, 0, 0, 0);
  od = __builtin_amdgcn_mfma_f32_32x32x16_bf16(pa1, PK(l1, h1), od, 0, 0, 0);
  od = __builtin_amdgcn_mfma_f32_32x32x16_bf16(pa2, PK(l2, h2), od, 0, 0, 0);
  od = __builtin_amdgcn_mfma_f32_32x32x16_bf16(pa3, PK(l3, h3), od, 0, 0, 0);
#undef PK
}
__device__ __forceinline__ void pv_d0(f32x16* o, int vb, bf16x8 pa0, bf16x8 pa1, bf16x8 pa2, bf16x8 pa3) {
  pv_one<0>(o[0], vb, pa0, pa1, pa2, pa3); pv_one<1>(o[1], vb, pa0, pa1, pa2, pa3); pv_one<2>(o[2], vb, pa0, pa1, pa2, pa3); pv_one<3>(o[3], vb, pa0, pa1, pa2, pa3);
}

template <typename TQ>
__device__ __forceinline__ void attn_dense_body(const TQ* __restrict__ Qb, const bf16* __restrict__ Kh, const bf16* __restrict__ Vh,
                                                float* __restrict__ Ob, int seq, char* lds) {
  using St = Stage<bf16>; using SQ = Stage<TQ>;
  const int tid = threadIdx.x, wid = tid >> 6, lane = tid & 63, r32 = lane & 31, hi = lane >> 5;
  bf16* V_lds = (bf16*)lds; bf16* K_lds = (bf16*)(lds + 2 * SHM_V);
  float* ws = (float*)(lds + 2 * SHM_V + 2 * SHM_K) + wid * 64; float* li_l = ws; float* al_l = ws + 32;
  float m_reg = -1e30f, l_reg = 0; f32x16 o[4] = {}; bf16x8 qr[8];
  const TQ* Qw = Qb + (long)(wid * QBLK + r32) * LDQ + hi * 8;
#pragma unroll
  for (int d0 = 0; d0 < 8; ++d0) qr[d0] = SQ::tobf(SQ::ld8(Qw + d0 * 16));
  const int sr = tid >> 4, sc = (tid & 15) * 8, vst0 = v_st(sr, sc), vst1 = v_st(32 + sr, sc);
  const int vb0 = (int)(uintptr_t)V_lds + v_rd_base(lane);
  struct { typename St::T vs0, vs1, ks0, ks1; } sr_[SDEPTH];
#define SLOAD(i, k0) do { sr_[i].vs0 = St::ld8(&Vh[(long)((k0) + sr) * LDK + sc]); sr_[i].vs1 = St::ld8(&Vh[(long)((k0) + 32 + sr) * LDK + sc]); \
    sr_[i].ks0 = St::ld8(&Kh[(long)((k0) + sr) * LDK + sc]); sr_[i].ks1 = St::ld8(&Kh[(long)((k0) + 32 + sr) * LDK + sc]); } while (0)
#define SWRITE(b, i) do { *(bf16x8*)((char*)V_lds + (b) * SHM_V + vst0) = St::tobf(sr_[i].vs0);          \
    *(bf16x8*)((char*)V_lds + (b) * SHM_V + vst1) = St::tobf(sr_[i].vs1); int kc = sc * 2;               \
    *(bf16x8*)((char*)K_lds + (b) * SHM_K + KSWZ(sr, kc)) = St::tobf(sr_[i].ks0);                       \
    *(bf16x8*)((char*)K_lds + (b) * SHM_K + KSWZ(32 + sr, kc)) = St::tobf(sr_[i].ks1); } while (0)
#define SWAIT() do { if constexpr (SDEPTH == 2) asm volatile("s_waitcnt vmcnt(4)" ::: "memory"); else asm volatile("s_waitcnt vmcnt(0)" ::: "memory"); } while (0)
#define RESC(a) do { if (__any((a) < 1.f)) { if (hi == 0) al_l[r32] = (a); asm volatile("s_waitcnt lgkmcnt(0)" ::: "memory"); \
    for (int d = 0; d < 4; ++d) for (int r = 0; r < 16; ++r) o[d][r] *= al_l[crow(r, hi)]; } } while (0)
  f32x16 pA0, pA1, pB0, pB1; float mnA, mnB, alA, alB; bf16x8 pa0, pa1, pa2, pa3; const int NT = seq / KVBLK;
  constexpr int SE = 0, SO = SDEPTH - 1;
  SLOAD(SE, 0); asm volatile("s_waitcnt vmcnt(0)" ::: "memory"); SWRITE(0, SE); __syncthreads();
  qkt(pA0, pA1, K_lds, qr, r32, hi); partialSM(pA0, pA1, m_reg, mnA, alA);
  SLOAD(SO, KVBLK); if constexpr (SDEPTH == 2) { if (2 < NT) SLOAD(SE, 2 * KVBLK); }
  SWAIT(); SWRITE(1, SO); __syncthreads();
  for (int j = 1; j + 1 < NT; j += 2) {
    SBAR(); qkt(pB0, pB1, (bf16*)((char*)K_lds + SHM_K), qr, r32, hi);
    finishSM(pA0, pA1, alA, l_reg, pa0, pa1, pa2, pa3); SBAR();
    SLOAD(SO, (j + SDEPTH) * KVBLK); SBAR();
    pv_d0(o, vb0, pa0, pa1, pa2, pa3); partialSM(pB0, pB1, m_reg, mnB, alB);
    __syncthreads(); SWAIT(); SWRITE(0, SE);
    RESC(alB); __syncthreads();
    SBAR(); qkt(pA0, pA1, K_lds, qr, r32, hi);
    finishSM(pB0, pB1, alB, l_reg, pa0, pa1, pa2, pa3); SBAR();
    if (SDEPTH == 1 || j + 3 < NT) SLOAD(SE, (j + 1 + SDEPTH) * KVBLK); SBAR();
    pv_d0(o, vb0 + (int)SHM_V, pa0, pa1, pa2, pa3); partialSM(pA0, pA1, m_reg, mnA, alA);
    __syncthreads(); SWAIT(); SWRITE(1, SO);
    RESC(alA); __syncthreads();
  }
  SBAR(); qkt(pB0, pB1, (bf16*)((char*)K_lds + SHM_K), qr, r32, hi);
  finishSM(pA0, pA1, alA, l_reg, pa0, pa1, pa2, pa3); SBAR();
  pv_d0(o, vb0, pa0, pa1, pa2, pa3); partialSM(pB0, pB1, m_reg, mnB, alB);
  __syncthreads(); RESC(alB);
  finishSM(pB0, pB1, alB, l_reg, pa0, pa1, pa2, pa3); SBAR();
  pv_d0(o, vb0 + (int)SHM_V, pa0, pa1, pa2, pa3);
  if (hi == 0) li_l[r32] = l_reg; asm volatile("s_waitcnt lgkmcnt(0)" ::: "memory");
  float rli[16];
#pragma unroll
  for (int r = 0; r < 16; ++r) rli[r] = __builtin_amdgcn_rcpf(li_l[crow(r, hi)]);
  float* Ow = Ob + (long)(wid * QBLK) * LDO;
#pragma unroll
  for (int r = 0; r < 16; ++r) { int orow = crow(r, hi);
    for (int d0 = 0; d0 < 4; ++d0) Ow[(long)orow * LDO + d0 * 32 + r32] = o[d0][r] * rli[r]; }
#undef SLOAD
#undef SWRITE
#undef SWAIT
#undef RESC
}
}
namespace att2 {
using att::bf16; using att::bf16x8; using att::s16x4; using att::f32x16; using att::u32x4;
typedef __bf16 bf16x2_nat __attribute__((ext_vector_type(2)));
typedef float f32x2_nat __attribute__((ext_vector_type(2)));
__device__ __forceinline__ unsigned cvtpk_safe(float lo, float hi) { return __builtin_bit_cast(unsigned, __builtin_convertvector((f32x2_nat){lo, hi}, bf16x2_nat)); }
constexpr int L_K = 0, L_V = 32768, L_P = 98304, L_L = 131072, L_PRM = 131072 + 512, LDS_NEED = 131072 + 512 + 32;
constexpr int LDQ = 12288, LDO = 8192;
__device__ __forceinline__ int v_st2(int k, int c) { const int kk = (k & ~0xC) | ((k & 4) << 1) | ((k & 8) >> 1); return ((kk >> 3) * 8 + (c >> 5)) * 512 + ((kk & 7) * 32 + (c & 31)) * 2; }
constexpr int v_rd_off2(int d0, int ks, int half) { return d0 * 512 + ks * 8192 + half * 4096; }
template <int D0> __device__ __forceinline__ void pv_one2(f32x16& od, int vb, bf16x8 pa0, bf16x8 pa1, bf16x8 pa2, bf16x8 pa3) {
  const s16x4 l0 = att::tr_read<v_rd_off2(D0, 0, 0)>(vb), h0 = att::tr_read<v_rd_off2(D0, 0, 1)>(vb), l1 = att::tr_read<v_rd_off2(D0, 1, 0)>(vb), h1 = att::tr_read<v_rd_off2(D0, 1, 1)>(vb);
  const s16x4 l2 = att::tr_read<v_rd_off2(D0, 2, 0)>(vb), h2 = att::tr_read<v_rd_off2(D0, 2, 1)>(vb), l3 = att::tr_read<v_rd_off2(D0, 3, 0)>(vb), h3 = att::tr_read<v_rd_off2(D0, 3, 1)>(vb);
  asm volatile("s_waitcnt lgkmcnt(0)" ::: "memory"); __builtin_amdgcn_sched_barrier(0);
#define PK(L, H) (bf16x8){L[0], L[1], L[2], L[3], H[0], H[1], H[2], H[3]}
  od = __builtin_amdgcn_mfma_f32_32x32x16_bf16(pa0, PK(l0, h0), od, 0, 0, 0);
  od = __builtin_amdgcn_mfma_f32_32x32x16_bf16(pa1, PK(l1, h1), od, 0, 0, 0);
  od = __builtin_amdgcn_mfma_f32_32x32x16_bf16(pa2, PK(l2, h2), od, 0, 0, 0);
  od = __builtin_amdgcn_mfma_f32_32x32x16_bf16(pa3, PK(l3, h3), od, 0, 0, 0);
#undef PK
}
typedef float f32x4q __attribute__((ext_vector_type(4)));
#define A2_QF(R, d) __builtin_bit_cast(bf16x8, (f32x4q){R[4 * (d)], R[4 * (d) + 1], R[4 * (d) + 2], R[4 * (d) + 3]})
__device__ __forceinline__ void qkt2(f32x16& p0, f32x16& p1, const bf16* Ks, const f32x16& Qa, const f32x16& Qb, int r32, int hi) {
  p0 = f32x16{}; p1 = f32x16{};
#pragma unroll
  for (int d0 = 0; d0 < 8; ++d0) { const int cb = (d0 * 16 + hi * 8) * 2;
    const bf16x8 b0 = *reinterpret_cast<const bf16x8*>((const char*)Ks + KSWZ(r32, cb));
    const bf16x8 b1 = *reinterpret_cast<const bf16x8*>((const char*)Ks + KSWZ(32 + r32, cb));
    const bf16x8 q = d0 < 4 ? A2_QF(Qa, d0) : A2_QF(Qb, d0 - 4);
    p0 = __builtin_amdgcn_mfma_f32_32x32x16_bf16(b0, q, p0, 0, 0, 0);
    p1 = __builtin_amdgcn_mfma_f32_32x32x16_bf16(b1, q, p1, 0, 0, 0); }
}
__device__ __forceinline__ void attn_unit(const bf16* __restrict__ Qb, const bf16* __restrict__ Kh, const bf16* __restrict__ Vh, float* Ob, int seq, float kmax2, char* lds, int MAP) {
  const int tid = threadIdx.x, wid = __builtin_amdgcn_readfirstlane(tid >> 6), lane = tid & 63, r32 = lane & 31, hi = lane >> 5;
  const bool prod = wid < 4; const int pair = wid & 3;
  const int sr = tid >> 4, sc = (tid & 15) * 8;
  const int kst0 = KSWZ(sr, sc * 2), kst1 = KSWZ(32 + sr, sc * 2);
  const int vst0 = v_st2(sr, sc), vst1 = v_st2(sr, 128 + sc), vst2 = v_st2(32 + sr, sc), vst3 = v_st2(32 + sr, 128 + sc);
  const int vb0 = (int)(uintptr_t)(lds + L_V) + att::v_rd_base(lane);
  char* mbox = lds + L_P + pair * 8192 + lane * 16;
  float* lrow = (float*)(lds + L_L) + pair * 32;
  constexpr float C = att::SCALE * 1.4426950408889634f;
  const int NT = seq / 64;
  bf16x8 ks0, ks1, vs0, vs1, vs2, vs3;
#define A2_SLOAD(k0) do { const bf16* _k = Kh + (size_t)((k0) + sr) * LDQ + sc; const bf16* _v = Vh + (size_t)((k0) + sr) * LDQ + sc; \
    ks0 = *(const bf16x8*)_k; ks1 = *(const bf16x8*)(_k + (size_t)32 * LDQ); vs0 = *(const bf16x8*)_v; vs1 = *(const bf16x8*)(_v + 128); vs2 = *(const bf16x8*)(_v + (size_t)32 * LDQ); vs3 = *(const bf16x8*)(_v + (size_t)32 * LDQ + 128); } while (0)
#define A2_KWRITE(b) do { char* _kb = lds + L_K + (b) * 16384; *(bf16x8*)(_kb + kst0) = ks0; *(bf16x8*)(_kb + kst1) = ks1; } while (0)
#define A2_VWRITE(b) do { char* _vb = lds + L_V + (b) * 32768; *(bf16x8*)(_vb + vst0) = vs0; *(bf16x8*)(_vb + vst1) = vs1; *(bf16x8*)(_vb + vst2) = vs2; *(bf16x8*)(_vb + vst3) = vs3; } while (0)
#define A2_SWRITE(b) do { A2_KWRITE(b); A2_VWRITE(b); } while (0)
  if (prod) {
    asm volatile("; producer role" ::: "memory");
    A2_SLOAD(0);
    bf16x8 qr[8]; float lsum = 0.f, qn = 0.f;
    const bf16* Qw = Qb + (size_t)(pair * 32 + r32) * LDQ + hi * 8;
#pragma unroll
    for (int d0 = 0; d0 < 8; ++d0) { qr[d0] = *(const bf16x8*)(Qw + d0 * 16);
#pragma unroll
      for (int e = 0; e < 8; ++e) { const float v = __builtin_bit_cast(float, ((unsigned)(unsigned short)qr[d0][e]) << 16); qn += v * v; } }
    { auto rr = __builtin_amdgcn_permlane32_swap(__float_as_uint(qn), __float_as_uint(qn), false, false); qn = __uint_as_float(rr[0]) + __uint_as_float(rr[1]); }
    const float mC = sqrtf(qn * kmax2) * C * 1.01f;
    A2_SWRITE(0); __syncthreads();
    if (1 < NT) A2_SLOAD(64);
    for (int j = 0; j < NT; ++j) {
      f32x16 p0, p1;
      att::qkt(p0, p1, (const bf16*)(lds + L_K + (j & 1) * 16384), qr, r32, hi);
#pragma unroll
      for (int r = 0; r < 16; ++r) { p0[r] = __builtin_amdgcn_exp2f(fmaf(p0[r], C, -mC)); p1[r] = __builtin_amdgcn_exp2f(fmaf(p1[r], C, -mC)); }
      float ps = 0.f;
#pragma unroll
      for (int r = 0; r < 16; ++r) ps += p0[r] + p1[r];
      lsum += ps;
      bf16x8 pa0, pa1, pa2, pa3;
#define PK4(P, BASE, OUT) do { unsigned a0 = cvtpk_safe(P[BASE + 0], P[BASE + 1]), a1 = cvtpk_safe(P[BASE + 2], P[BASE + 3]);   \
    unsigned b0 = cvtpk_safe(P[BASE + 4], P[BASE + 5]), b1 = cvtpk_safe(P[BASE + 6], P[BASE + 7]);                              \
    auto r0 = __builtin_amdgcn_permlane32_swap(a0, b0, false, false); auto r1 = __builtin_amdgcn_permlane32_swap(a1, b1, false, false); \
    u32x4 w = {r0[0], r1[0], r0[1], r1[1]}; OUT = *reinterpret_cast<bf16x8*>(&w); } while (0)
      PK4(p0, 0, pa0); PK4(p0, 8, pa1); PK4(p1, 0, pa2); PK4(p1, 8, pa3);
#undef PK4
      char* mb = mbox + (j & 1) * 4096;
      *(bf16x8*)(mb) = pa0; *(bf16x8*)(mb + 1024) = pa1; *(bf16x8*)(mb + 2048) = pa2; *(bf16x8*)(mb + 3072) = pa3;
      if (j + 1 < NT) A2_KWRITE((j + 1) & 1);
      __syncthreads();
      if (j + 1 < NT) { A2_VWRITE((j + 1) & 1); if (j + 2 < NT) A2_SLOAD((j + 2) * 64); }
    }
    { auto rr = __builtin_amdgcn_permlane32_swap(__float_as_uint(lsum), __float_as_uint(lsum), false, false); lsum = __uint_as_float(rr[0]) + __uint_as_float(rr[1]); }
    if (hi == 0) lrow[r32] = lsum;
    __syncthreads();
  } else {
    f32x16 o[8];
#pragma unroll
    for (int d = 0; d < 8; ++d) o[d] = f32x16{};
    asm volatile("; consumer role" ::: "memory");
    A2_SLOAD(0);
    A2_SWRITE(0); __syncthreads();
    if (1 < NT) A2_SLOAD(64);
    for (int j = 0; j <= NT; ++j) {
      if (j >= 1) {
        const char* mb = mbox + ((j - 1) & 1) * 4096;
        const bf16x8 pa0 = *(const bf16x8*)(mb), pa1 = *(const bf16x8*)(mb + 1024), pa2 = *(const bf16x8*)(mb + 2048), pa3 = *(const bf16x8*)(mb + 3072);
        const int vb = vb0 + ((j - 1) & 1) * 32768;
        pv_one2<0>(o[0], vb, pa0, pa1, pa2, pa3); pv_one2<1>(o[1], vb, pa0, pa1, pa2, pa3); pv_one2<2>(o[2], vb, pa0, pa1, pa2, pa3); pv_one2<3>(o[3], vb, pa0, pa1, pa2, pa3);
        pv_one2<4>(o[4], vb, pa0, pa1, pa2, pa3); pv_one2<5>(o[5], vb, pa0, pa1, pa2, pa3); pv_one2<6>(o[6], vb, pa0, pa1, pa2, pa3); pv_one2<7>(o[7], vb, pa0, pa1, pa2, pa3);
      }
      if (j == NT) break;
      if (j + 1 < NT) A2_KWRITE((j + 1) & 1);
      __syncthreads();
      if (j + 1 < NT) { A2_VWRITE((j + 1) & 1); if (j + 2 < NT) A2_SLOAD((j + 2) * 64); }
    }
    __syncthreads();
    float* Ow = Ob + (size_t)(pair * 32) * LDO;
    int r32o = r32, hio = hi; asm volatile("" : "+v"(r32o), "+v"(hio) :: "memory");
    if (MAP == 0) {
#pragma unroll
      for (int r = 0; r < 16; ++r) { const int orow = att::crow(r, hio); const float rl = __builtin_amdgcn_rcpf(lrow[orow]);
#pragma unroll
        for (int d0 = 0; d0 < 8; ++d0) Ow[(size_t)orow * LDO + d0 * 32 + r32o] = o[d0][r] * rl; }
    } else {
      const float nl = -__uint_as_float(__builtin_amdgcn_readfirstlane(*(const unsigned*)(lds + L_PRM))), post = __uint_as_float(__builtin_amdgcn_readfirstlane(*(const unsigned*)(lds + L_PRM + 4)));
      const unsigned long long p_sg = (unsigned long long)(unsigned)__builtin_amdgcn_readfirstlane(*(const unsigned*)(lds + L_PRM + 8)) | ((unsigned long long)(unsigned)__builtin_amdgcn_readfirstlane(*(const unsigned*)(lds + L_PRM + 12)) << 32);
      const unsigned long long p_y0 = (unsigned long long)(unsigned)__builtin_amdgcn_readfirstlane(*(const unsigned*)(lds + L_PRM + 16)) | ((unsigned long long)(unsigned)__builtin_amdgcn_readfirstlane(*(const unsigned*)(lds + L_PRM + 20)) << 32);
      const unsigned long long p_a2 = (unsigned long long)(unsigned)__builtin_amdgcn_readfirstlane(*(const unsigned*)(lds + L_PRM + 24)) | ((unsigned long long)(unsigned)__builtin_amdgcn_readfirstlane(*(const unsigned*)(lds + L_PRM + 28)) << 32);
      const float* sub_gain = (const float*)p_sg;
      const size_t off = (size_t)(Ob - (float*)p_y0);
      unsigned short* Aw = (unsigned short*)p_a2 + (off >> 13) * 4096 + (off & 8191) + (size_t)(pair * 32) * 4096;
      float sg[8];
#pragma unroll
      for (int d0 = 0; d0 < 8; ++d0) sg[d0] = sub_gain[d0 * 32 + r32o];
#define A2_CMB(RG, NB) do { float o1[NB][8];                                                                                                                   \
        _Pragma("unroll") for (int k = 0; k < NB; ++k) { const int orow = att::crow(RG + k, hio);                                                               \
          _Pragma("unroll") for (int d0 = 0; d0 < 8; ++d0) o1[k][d0] = Ow[(size_t)orow * LDO + d0 * 32 + r32o]; }                                               \
        asm volatile("" ::: "memory");                                                                                                                         \
        _Pragma("unroll") for (int k = 0; k < NB; ++k) { const int r = RG + k; const int orow = att::crow(r, hio);                                              \
          float dv[8], ss = 0.f; float rl = __builtin_amdgcn_rcpf(lrow[orow]); asm volatile("" : "+v"(rl));                                                     \
          _Pragma("unroll") for (int d0 = 0; d0 < 8; ++d0) { dv[d0] = fmaf(nl, o[d0][r] * rl, o1[k][d0]); ss += dv[d0] * dv[d0]; }                              \
          ss += __shfl_xor(ss, 1); ss += __shfl_xor(ss, 2); ss += __shfl_xor(ss, 4); ss += __shfl_xor(ss, 8); ss += __shfl_xor(ss, 16);                          \
          const float rs = rsqrtf(ss * (1.f / 256.f) + 1e-6f) * post;                                                                                          \
          _Pragma("unroll") for (int d0 = 0; d0 < 8; ++d0) { const float w = dv[d0] * rs * sg[d0]; Aw[(size_t)orow * 4096 + d0 * 32 + r32o] = (unsigned short)(cvtpk_safe(w, w) & 0xffffu); } } \
        asm volatile("" ::: "memory"); } while (0)
      A2_CMB(0, 2); A2_CMB(2, 2); A2_CMB(4, 2); A2_CMB(6, 2); A2_CMB(8, 4); A2_CMB(12, 4);
#undef A2_CMB
    }
  }
  __syncthreads();
#undef A2_SLOAD
#undef A2_SWRITE
#undef A2_KWRITE
#undef A2_VWRITE
}
}
constexpr int NWAVES = 8;
constexpr int DM = 4096, TL = 8192, TC = 256, TT = TL + TC, DEPTH = 4;
constexpr int MODW = 6 * DM;
constexpr int SSD_ZXW = 18432, SSD_INC = 18688, SSD_CC = 10240;
constexpr float RMS_EPS = 1e-6f;
typedef unsigned short bf16;
typedef unsigned v4u __attribute__((ext_vector_type(4)));
typedef unsigned v2u __attribute__((ext_vector_type(2)));
typedef float f32x4 __attribute__((ext_vector_type(4)));
typedef float f32x2 __attribute__((ext_vector_type(2)));
#define LAS __attribute__((address_space(3)))

constexpr size_t MiB = 1u << 20;
constexpr size_t al256(size_t x) { return (x + 255) & ~(size_t)255; }
constexpr size_t WS_CTL = 0, CTL_BYTES = 1 * MiB;
constexpr size_t WS_MOD = WS_CTL + CTL_BYTES;
constexpr size_t WS_ROPE = WS_MOD + al256((size_t)DEPTH * 2 * MODW * 4);
constexpr size_t WS_WUP = WS_ROPE + al256(128 * 32 * 2 * 4);
constexpr size_t WS_WDN = WS_WUP + (size_t)4 * 8192 * 4096 * 2;
constexpr size_t WS_WSI = WS_WDN + (size_t)4 * 4096 * 4096 * 2;
constexpr size_t WS_WSO = WS_WSI + (size_t)2 * 18688 * 4096 * 2;
constexpr size_t WS_WGL = WS_WSO + (size_t)2 * 4096 * 8192 * 2;
constexpr size_t WS_WQKV = WS_WGL + (size_t)8192 * 4096 * 2;
constexpr size_t WS_WO = WS_WQKV + (size_t)12288 * 4096 * 2;
constexpr size_t WS_X = WS_WO + (size_t)4096 * 4096 * 2;
constexpr size_t WS_H = WS_X + (size_t)TT * DM * 4;
constexpr size_t WS_BIG = WS_H + (size_t)TT * DM * 2;
constexpr size_t WS_DT = WS_BIG + (size_t)TT * SSD_ZXW * 2;
constexpr size_t WS_XBC = WS_DT + (size_t)TT * 256 * 4;
constexpr size_t WS_Y0 = WS_XBC + (size_t)TT * SSD_CC * 2;
constexpr size_t WS_Y1 = WS_Y0 + (size_t)TT * 8192 * 4;
constexpr size_t WS_A2 = WS_Y1 + (size_t)TT * 8192 * 4;
constexpr size_t WS_END = WS_A2 + (size_t)TT * 8192 * 2;
constexpr int CW_BAR = 4096, CW_KMAX = 16384;

constexpr int RING_BYTES = 131072, LDSCTL_OFF = 146432, MISC_OFF = LDSCTL_OFF + 320, LDS_BYTES = 147456;

__device__ __forceinline__ float bf2f(unsigned b) { return __builtin_bit_cast(float, b << 16); }
__device__ __forceinline__ float bflo(unsigned w) { return __builtin_bit_cast(float, w << 16); }
__device__ __forceinline__ float bfhi(unsigned w) { return __builtin_bit_cast(float, w & 0xffff0000u); }
__device__ __forceinline__ unsigned pk2(float lo, float hi) { return pg8::cvt_pk_bf16(lo, hi); }
__device__ __forceinline__ float wave_sum(float v) {
#pragma unroll
    for (int o = 1; o < 64; o <<= 1) v += __shfl_xor(v, o);
    return v;
}
__device__ __forceinline__ float silu_f(float x) { return x * __builtin_amdgcn_rcpf(1.f + __expf(-x)); }
__device__ __forceinline__ float sigmoid_f(float x) { return __builtin_amdgcn_rcpf(1.f + __expf(-x)); }
__device__ __forceinline__ float gelu_tanh_f(float x) { const float z = 0.7978845608028654f * (x + 0.044715f * x * x * x); return x * __builtin_amdgcn_rcpf(1.f + __expf(-2.f * z)); }
#define LDS_WAIT() asm volatile("s_waitcnt lgkmcnt(0)" ::: "memory")

#define XB_TMO      128
#define XB_XCNT(j)  (256  + 64 * (j))
#define XB_XSUB(j)  (1280 + 64 * (j))
#define XB_XGEN(j)  (2304 + 64 * (j))
#define XB_TOP      3328
#define XB_TOPGEN   3392
#define XCD_BAR_WORDS 3456
#define XB_SPIN_CAP (1u << 18)

__device__ __forceinline__ unsigned xb_ld(unsigned* p)              { return __hip_atomic_load(p, __ATOMIC_RELAXED, __HIP_MEMORY_SCOPE_AGENT); }
__device__ __forceinline__ unsigned xb_add(unsigned* p, unsigned v) { return __hip_atomic_fetch_add(p, v, __ATOMIC_RELAXED, __HIP_MEMORY_SCOPE_AGENT); }
__device__ __forceinline__ unsigned xb_xcc_id() { return (unsigned)__builtin_amdgcn_s_getreg((3 << 11) | 20) & 0xFu; }
#define XB_SPIN(cond, bar) do { unsigned _sp = 0; while (cond) { __builtin_amdgcn_s_sleep(1); \
    if ((++_sp & 255u) == 0u) { if (xb_ld(&(bar)[XB_TMO])) break; if (_sp > XB_SPIN_CAP) { atomicAdd(&(bar)[XB_TMO], 1u); break; } } } } while (0)

struct XcdBarrier {
    unsigned* bar; unsigned x;
    volatile LAS unsigned* st;
};

__device__ __forceinline__ XcdBarrier xcd_barrier_post(unsigned* bar, volatile LAS unsigned* st) {
    XcdBarrier b; b.bar = bar; b.x = xb_xcc_id(); b.st = st;
    if (threadIdx.x == 0) (void)xb_add(&bar[XB_XCNT(b.x)], 1u);
    return b;
}
__device__ __forceinline__ void xcd_barrier_complete(unsigned* bar, unsigned x, unsigned& nloc, unsigned& nx) {
    const unsigned G = gridDim.x * gridDim.y * gridDim.z;
    unsigned sum, cnt, mine, sp = 0u;
    for (;;) {
        sum = 0u; cnt = 0u; mine = 0u;
#pragma unroll
        for (unsigned j = 0; j < 16; ++j) { const unsigned c = xb_ld(&bar[XB_XCNT(j)]); sum += c; cnt += (c > 0u) ? 1u : 0u; mine = (j == x) ? c : mine; }
        if (sum == G) break;
        __builtin_amdgcn_s_sleep(1);
        if ((++sp & 255u) == 0u) { if (xb_ld(&bar[XB_TMO])) break; if (sp > XB_SPIN_CAP) { atomicAdd(&bar[XB_TMO], 1u); break; } }
    }
    nloc = mine > 0u ? mine : 1u; nx = cnt > 0u ? cnt : 1u;
}

__device__ __forceinline__ void xcd_barrier(const XcdBarrier& b) {
    asm volatile("s_waitcnt vmcnt(0)" ::: "memory");
    __syncthreads();
    if (threadIdx.x == 0) {
        unsigned* bar = b.bar;
        __builtin_amdgcn_s_waitcnt(0);
        unsigned nloc = b.st[0], nx = b.st[1];
        if (nloc == 0u) { xcd_barrier_complete(bar, b.x, nloc, nx); b.st[0] = nloc; b.st[1] = nx; }
        const unsigned old = xb_add(&bar[XB_XSUB(b.x)], 1u);
        const unsigned gen = old / nloc;
        if (old + 1u == (gen + 1u) * nloc) {
            __builtin_amdgcn_fence(__ATOMIC_RELEASE, "agent");
            asm volatile("s_waitcnt vmcnt(0)" ::: "memory");
            const unsigned og = xb_add(&bar[XB_TOP], 1u);
            const unsigned tg = og / nx;
            if (og + 1u == (tg + 1u) * nx) xb_add(&bar[XB_TOPGEN], 1u);
            else XB_SPIN(xb_ld(&bar[XB_TOPGEN]) == tg, bar);
            __builtin_amdgcn_fence(__ATOMIC_ACQUIRE, "agent");
            xb_add(&bar[XB_XGEN(b.x)], 1u);
            asm volatile("s_waitcnt vmcnt(0)" ::: "memory");
        } else {
            XB_SPIN(xb_ld(&bar[XB_XGEN(b.x)]) == gen, bar);
            __builtin_amdgcn_fence(__ATOMIC_ACQUIRE, "agent");
            asm volatile("s_waitcnt vmcnt(0)" ::: "memory");
        }
    }
    __syncthreads();
}

__device__ __forceinline__ void transpose_item(const float* W, int K, int N, bf16* WT, int row_off, LAS float* scr, int item, int lane) {
    const int nblk = N / 32, kb = item / nblk, nb = item % nblk, k0 = 64 * kb, n0 = 32 * nb;
    float tv[32];
#pragma unroll
    for (int i = 0; i < 32; ++i) tv[i] = W[(size_t)(k0 + 2 * i + (lane >> 5)) * N + n0 + (lane & 31)];
#pragma unroll
    for (int i = 0; i < 32; ++i) scr[(2 * i + (lane >> 5)) * 33 + (lane & 31)] = tv[i];
    LDS_WAIT(); asm volatile("" ::: "memory");
    const int c = lane & 7;
#pragma unroll
    for (int j = 0; j < 4; ++j) { const int n = (lane >> 3) + 8 * j; const LAS float* s = scr + (8 * c) * 33 + n;
        v4u o; o.x = pk2(s[0 * 33], s[1 * 33]); o.y = pk2(s[2 * 33], s[3 * 33]); o.z = pk2(s[4 * 33], s[5 * 33]); o.w = pk2(s[6 * 33], s[7 * 33]);
        *(v4u*)(WT + (size_t)(row_off + n0 + n) * K + k0 + 8 * c) = o; }
    LDS_WAIT(); asm volatile("" ::: "memory");
}
__device__ __forceinline__ void transpose_matrix(const float* W, int K, int N, bf16* WT, int row_off, LAS float* scr, int gw, int NGW, int lane) {
    const int nitems = (K / 64) * (N / 32);
    for (int it = gw; it < nitems; it += NGW) transpose_item(W, K, N, WT, row_off, scr, it, lane);
}

__device__ __forceinline__ void mod_phase(const float* c_lat, const float* c_ctx, const float* mod_w, const float* mod_b, float* MOD, LAS unsigned char* lds, int tid, int wave, int lane) {
    LAS float* S = (LAS float*)lds;
    LAS float* RED = (LAS float*)(lds + 32768);
    for (int k = tid; k < DM; k += NWAVES * 64) { S[k] = silu_f(c_lat[k]); S[DM + k] = silu_f(c_ctx[k]); }
    __syncthreads();
    for (int item = blockIdx.x; item < DEPTH * 192; item += gridDim.x) {
        const int l = item / 192, n0 = (item % 192) * 128;
        const float* W = mod_w + (size_t)l * DM * MODW + n0 + 2 * lane;
        f32x2 a0 = {0.f, 0.f}, a1 = {0.f, 0.f};
        const int kb = wave * 512;
#pragma unroll 16
        for (int k = 0; k < 512; ++k) { const f32x2 wv = *(const f32x2*)(W + (size_t)(kb + k) * MODW); const float s0 = S[kb + k], s1 = S[DM + kb + k]; a0 += wv * s0; a1 += wv * s1; }
        RED[(wave * 2 + 0) * 128 + 2 * lane] = a0.x; RED[(wave * 2 + 0) * 128 + 2 * lane + 1] = a0.y;
        RED[(wave * 2 + 1) * 128 + 2 * lane] = a1.x; RED[(wave * 2 + 1) * 128 + 2 * lane + 1] = a1.y;
        __syncthreads();
        if (tid < 256) { const int v = tid >> 7, n = tid & 127; float s = 0.f;
#pragma unroll
            for (int w = 0; w < 8; ++w) s += RED[(w * 2 + v) * 128 + n];
            MOD[(size_t)(l * 2 + v) * MODW + n0 + n] = s + mod_b[(size_t)l * MODW + n0 + n]; }
        __syncthreads();
    }
}

__device__ __forceinline__ void norm_mod_phase(const bf16* X, const float* gain, const float* modL, int sh_off, int sc_off, bf16* H, int gw, int NGW, int lane, const float* Xc = nullptr, const float* Xl = nullptr) {
    const int NMAIN = (TT / NGW) * NGW;
    for (int r = gw; r < NMAIN; r += NGW) {
        f32x4 v[8][2]; float ss = 0.f;
        if (Xl) { const float* xr = r < TC ? Xc + (size_t)r * DM : Xl + (size_t)(r - TC) * DM;
#pragma unroll
            for (int j = 0; j < 8; ++j) { v[j][0] = *(const f32x4*)(xr + 8 * (lane + 64 * j)); v[j][1] = *(const f32x4*)(xr + 8 * (lane + 64 * j) + 4); }
        } else { const bf16* xr = X + (size_t)r * DM; v4u xb[8];
#pragma unroll
            for (int j = 0; j < 8; ++j) xb[j] = *(const v4u*)(xr + 8 * (lane + 64 * j));
#pragma unroll
            for (int j = 0; j < 8; ++j) { v[j][0] = f32x4{bflo(xb[j].x), bfhi(xb[j].x), bflo(xb[j].y), bfhi(xb[j].y)}; v[j][1] = f32x4{bflo(xb[j].z), bfhi(xb[j].z), bflo(xb[j].w), bfhi(xb[j].w)}; } }
#pragma unroll
        for (int j = 0; j < 8; ++j)
#pragma unroll
            for (int h = 0; h < 2; ++h) ss += (v[j][h].x * v[j][h].x + v[j][h].y * v[j][h].y) + (v[j][h].z * v[j][h].z + v[j][h].w * v[j][h].w);
        ss = wave_sum(ss); const float rs = rsqrtf(ss * (1.f / DM) + RMS_EPS);
        const float* md = modL + (r < TC ? MODW : 0);
#pragma unroll
        for (int j = 0; j < 8; ++j) { const int c = 8 * (lane + 64 * j);
            f32x4 o[2];
#pragma unroll
            for (int h = 0; h < 2; ++h) { const f32x4 g = *(const f32x4*)(gain + c + 4 * h), sc = *(const f32x4*)(md + sc_off + c + 4 * h), sh = *(const f32x4*)(md + sh_off + c + 4 * h);
                o[h] = (v[j][h] * rs) * g * (sc + 1.f) + sh; }
            v4u w; w.x = pk2(o[0].x, o[0].y); w.y = pk2(o[0].z, o[0].w); w.z = pk2(o[1].x, o[1].y); w.w = pk2(o[1].z, o[1].w); *(v4u*)(H + (size_t)r * DM + c) = w; }
    }
    {
        extern __shared__ __attribute__((aligned(16))) unsigned char lds_norm_raw[];
        LAS float* red = (LAS float*)((LAS unsigned char*)lds_norm_raw + LDSCTL_OFF);
        const int wv = gw & (NWAVES - 1), wg = blockIdx.x, nwg = NGW / NWAVES;
        for (int r = NMAIN + wg; r < TT; r += nwg) {
            const int c0 = 512 * wv + 4 * lane;
            f32x4 v0, v1;
            if (Xl) { const float* xr = r < TC ? Xc + (size_t)r * DM : Xl + (size_t)(r - TC) * DM; v0 = *(const f32x4*)(xr + c0); v1 = *(const f32x4*)(xr + c0 + 256); }
            else { const bf16* xr = X + (size_t)r * DM; const v2u b0 = *(const v2u*)(xr + c0), b1 = *(const v2u*)(xr + c0 + 256);
                v0 = f32x4{bflo(b0.x), bfhi(b0.x), bflo(b0.y), bfhi(b0.y)}; v1 = f32x4{bflo(b1.x), bfhi(b1.x), bflo(b1.y), bfhi(b1.y)}; }
            float ss = wave_sum((v0.x * v0.x + v0.y * v0.y) + (v0.z * v0.z + v0.w * v0.w) + (v1.x * v1.x + v1.y * v1.y) + (v1.z * v1.z + v1.w * v1.w));
            __syncthreads();
            if (lane == 0) red[wv] = ss;
            __syncthreads();
            float tot = 0.f;
#pragma unroll
            for (int k = 0; k < NWAVES; ++k) tot += red[k];
            const float rs = rsqrtf(tot * (1.f / DM) + RMS_EPS);
            const float* md = modL + (r < TC ? MODW : 0);
#pragma unroll
            for (int h = 0; h < 2; ++h) { const int c = c0 + 256 * h; const f32x4 vv = h ? v1 : v0;
                const f32x4 g = *(const f32x4*)(gain + c), sc = *(const f32x4*)(md + sc_off + c), sh = *(const f32x4*)(md + sh_off + c);
                const f32x4 o = (vv * rs) * g * (sc + 1.f) + sh;
                v2u w; w.x = pk2(o.x, o.y); w.y = pk2(o.z, o.w); *(v2u*)(H + (size_t)r * DM + c) = w; }
        }
    }
}

__device__ __forceinline__ void ssd_conv_phase(const bf16* __restrict__ ZX, const float* __restrict__ cw, const float* __restrict__ cb, bf16* __restrict__ XBC, int gw, int NGW, int lane) {
    constexpr int NRB = TT / 8, NCB = SSD_CC / 512;
    const int nwv = NGW / NCB;
    f32x2 w[5][4], b[4];
    int cbk_have = -1;
    const int it_step = nwv >= 1 ? nwv * NCB : NGW;
    if (nwv >= 1 && gw >= nwv * NCB) return;
    for (int it = gw; it < NRB * NCB; it += it_step) {
        const int rb = it / NCB, cbk = it % NCB, r0 = rb * 8, c = cbk * 512 + lane * 8;
        const int seg_lo = (r0 < TC) ? 0 : TC, seg_hi = (r0 < TC) ? TC : TT;
        v4u win[12];
#pragma unroll
        for (int j = 0; j < 12; ++j) win[j] = (v4u){0u, 0u, 0u, 0u};
        if (r0 - 2 >= seg_lo && r0 + 10 <= seg_hi) {
#pragma unroll
            for (int j = 0; j < 12; ++j) win[j] = *(const v4u*)(ZX + (size_t)(r0 - 2 + j) * SSD_ZXW + 8192 + c);
        } else {
#pragma unroll
            for (int j = 0; j < 12; ++j) { const int rr = r0 - 2 + j; if (rr >= seg_lo && rr < seg_hi) win[j] = *(const v4u*)(ZX + (size_t)rr * SSD_ZXW + 8192 + c); } }
        if (cbk != cbk_have) { cbk_have = cbk;
#pragma unroll
            for (int j = 0; j < 5; ++j) { const f32x4 a0 = *(const f32x4*)(cw + (size_t)j * SSD_CC + c), a1 = *(const f32x4*)(cw + (size_t)j * SSD_CC + c + 4);
                w[j][0] = f32x2{a0.x, a0.y}; w[j][1] = f32x2{a0.z, a0.w}; w[j][2] = f32x2{a1.x, a1.y}; w[j][3] = f32x2{a1.z, a1.w}; }
            { const f32x4 a0 = *(const f32x4*)(cb + c), a1 = *(const f32x4*)(cb + c + 4); b[0] = f32x2{a0.x, a0.y}; b[1] = f32x2{a0.z, a0.w}; b[2] = f32x2{a1.x, a1.y}; b[3] = f32x2{a1.z, a1.w}; } }
#pragma unroll
        for (int i = 0; i < 8; ++i) {
            f32x2 o[4];
#pragma unroll
            for (int q = 0; q < 4; ++q) o[q] = b[q];
#pragma unroll
            for (int j = 0; j < 5; ++j) {
#pragma unroll
                for (int q = 0; q < 4; ++q) o[q] += w[j][q] * f32x2{bflo(win[i + j][q]), bfhi(win[i + j][q])}; }
            v4u ov; ov.x = pk2(silu_f(o[0].x), silu_f(o[0].y)); ov.y = pk2(silu_f(o[1].x), silu_f(o[1].y)); ov.z = pk2(silu_f(o[2].x), silu_f(o[2].y)); ov.w = pk2(silu_f(o[3].x), silu_f(o[3].y));
            *(v4u*)(XBC + (size_t)(r0 + i) * SSD_CC + c) = ov; }
    }
}

__device__ __forceinline__ void ffn_conv_phase(const bf16* __restrict__ U, const float* __restrict__ cw, const float* __restrict__ cb, bf16* __restrict__ G, int gw, int NGW, int lane) {
    constexpr int NRB = TT / 8, NCB = 4096 / 512;
    f32x2 wg[3][4], wv[3][4], bg[4], bv[4];
    int cbk_have = -1;
    for (int it = gw; it < NRB * NCB; it += NGW) {
        const int rb = it / NCB, cbk = it % NCB, r0 = rb * 8, c = cbk * 512 + lane * 8;
        const int seg_lo = (r0 < TC) ? 0 : TC, seg_hi = (r0 < TC) ? TC : TT;
        v4u wing[10], winv[10];
#pragma unroll
        for (int j = 0; j < 10; ++j) { wing[j] = (v4u){0u, 0u, 0u, 0u}; winv[j] = (v4u){0u, 0u, 0u, 0u}; }
        if (r0 - 1 >= seg_lo && r0 + 9 <= seg_hi) {
#pragma unroll
            for (int j = 0; j < 10; ++j) { wing[j] = *(const v4u*)(U + (size_t)(r0 - 1 + j) * 8192 + c); winv[j] = *(const v4u*)(U + (size_t)(r0 - 1 + j) * 8192 + 4096 + c); }
        } else {
#pragma unroll
            for (int j = 0; j < 10; ++j) { const int rr = r0 - 1 + j; if (rr >= seg_lo && rr < seg_hi) { wing[j] = *(const v4u*)(U + (size_t)rr * 8192 + c); winv[j] = *(const v4u*)(U + (size_t)rr * 8192 + 4096 + c); } } }
        if (cbk != cbk_have) { cbk_have = cbk;
#pragma unroll
        for (int j = 0; j < 3; ++j) {
            const f32x4 a0 = *(const f32x4*)(cw + (size_t)j * 8192 + c), a1 = *(const f32x4*)(cw + (size_t)j * 8192 + c + 4);
            const f32x4 d0 = *(const f32x4*)(cw + (size_t)j * 8192 + 4096 + c), d1 = *(const f32x4*)(cw + (size_t)j * 8192 + 4096 + c + 4);
            wg[j][0] = f32x2{a0.x, a0.y}; wg[j][1] = f32x2{a0.z, a0.w}; wg[j][2] = f32x2{a1.x, a1.y}; wg[j][3] = f32x2{a1.z, a1.w};
            wv[j][0] = f32x2{d0.x, d0.y}; wv[j][1] = f32x2{d0.z, d0.w}; wv[j][2] = f32x2{d1.x, d1.y}; wv[j][3] = f32x2{d1.z, d1.w}; }
        { const f32x4 a0 = *(const f32x4*)(cb + c), a1 = *(const f32x4*)(cb + c + 4), d0 = *(const f32x4*)(cb + 4096 + c), d1 = *(const f32x4*)(cb + 4096 + c + 4);
          bg[0] = f32x2{a0.x, a0.y}; bg[1] = f32x2{a0.z, a0.w}; bg[2] = f32x2{a1.x, a1.y}; bg[3] = f32x2{a1.z, a1.w};
          bv[0] = f32x2{d0.x, d0.y}; bv[1] = f32x2{d0.z, d0.w}; bv[2] = f32x2{d1.x, d1.y}; bv[3] = f32x2{d1.z, d1.w}; } }
#pragma unroll
        for (int i = 0; i < 8; ++i) {
            f32x2 og[4], ov[4];
#pragma unroll
            for (int q = 0; q < 4; ++q) { og[q] = bg[q]; ov[q] = bv[q]; }
#pragma unroll
            for (int j = 0; j < 3; ++j) {
#pragma unroll
                for (int q = 0; q < 4; ++q) { og[q] += wg[j][q] * f32x2{bflo(wing[i + j][q]), bfhi(wing[i + j][q])}; ov[q] += wv[j][q] * f32x2{bflo(winv[i + j][q]), bfhi(winv[i + j][q])}; } }
            v4u o; o.x = pk2(silu_f(og[0].x) * ov[0].x, silu_f(og[0].y) * ov[0].y); o.y = pk2(silu_f(og[1].x) * ov[1].x, silu_f(og[1].y) * ov[1].y);
            o.z = pk2(silu_f(og[2].x) * ov[2].x, silu_f(og[2].y) * ov[2].y); o.w = pk2(silu_f(og[3].x) * ov[3].x, silu_f(og[3].y) * ov[3].y);
            *(v4u*)(G + (size_t)(r0 + i) * 4096 + c) = o; }
    }
}

typedef short bf16x8_t __attribute__((ext_vector_type(8)));
typedef short s16x4_t __attribute__((ext_vector_type(4)));
constexpr int SS_RS = 272, SS_RX = 144;
constexpr int SS_BT = 0, SS_CT = 34816, SS_BW = 69632, SS_XN = 104448, SS_HT = 122880, SS_CUM = 141312;
static_assert(SS_CUM + 4096 <= LDSCTL_OFF, "SSD scan LDS map");
__device__ __forceinline__ int ssd_chunk_base(int dir, int j) { return dir == 0 ? 128 * j : (j < 2 ? TC - 128 * (j + 1) : TT - 128 * (j - 1)); }
template <int OFF> __device__ __forceinline__ v2u tr_read8(unsigned addr) { v2u r; asm volatile("ds_read_b64_tr_b16 %0, %1 offset:%2" : "=&v"(r) : "v"(addr), "i"(OFF) : "memory"); return r; }
__device__ __forceinline__ v2u tr_read8_dyn(unsigned addr, int off) { v2u r; asm volatile("ds_read_b64_tr_b16 %0, %1 offset:%2" : "=&v"(r) : "v"(addr), "n"(off) : "memory"); return r; }
#define SS_LGKM_WAIT() do { asm volatile("s_waitcnt lgkmcnt(0)" ::: "memory"); __builtin_amdgcn_sched_barrier(0); } while (0)
__device__ __forceinline__ void ssd_scan_phase(const bf16* XBC, const float* DT, const float* a_log, const float* d_skip, bf16* YF, bf16* YB, LAS unsigned char* lds, int tid) {
    const int lane = tid & 63, w = __builtin_amdgcn_readfirstlane(tid >> 6), wq = tid >> 6, i = lane & 15, q = lane >> 4;
    const int srow = tid >> 2, sseg = tid & 3;
    const int tq = (lane >> 2) & 3, tp = lane & 3;
    const unsigned ldsb = (unsigned)(size_t)lds;
    const unsigned trb_x4 = ldsb + SS_XN + (4 * q + tq) * SS_RX + 8 * tp, trb_x8 = ldsb + SS_XN + (8 * q + tq) * SS_RX + 8 * tp;
    const unsigned trb_h8 = ldsb + SS_HT + (8 * q + tq) * SS_RX + 8 * tp, trb_b8 = ldsb + SS_BW + (8 * q + tq) * SS_RS + (16 * wq + 4 * tp) * 2;
    for (int u = blockIdx.x; u < 256; u += gridDim.x) {
        const int dir = u >> 7, head = u & 127, g = head >> 4;
        const float a = -__expf(a_log[dir * 128 + head]);
        const float dsk = d_skip[head];
        bf16* Y = dir ? YB : YF;
        f32x4 Hm[4];
#pragma unroll
        for (int pt = 0; pt < 4; ++pt) Hm[pt] = (f32x4){0.f, 0.f, 0.f, 0.f};
        float pen[4];
#pragma unroll
        for (int r = 0; r < 4; ++r) pen[r] = (dir ? (4 * q + r >= i) : (4 * q + r <= i)) ? 0.f : -1e30f;
        v4u rb[4], rc[4], rx[2]; float rd0 = 0.f, rd1 = 0.f;
        const int e0 = dir ? 127 - 2 * lane : 2 * lane, e1 = dir ? e0 - 1 : e0 + 1;
#define SSD_LOAD(j) do { const int _b = ssd_chunk_base(dir, (j)); const bf16* _p = XBC + (size_t)(_b + srow) * SSD_CC; \
        _Pragma("unroll") for (int k = 0; k < 4; ++k) { rb[k] = *(const v4u*)(_p + 8192 + g * 128 + sseg * 32 + 8 * k); rc[k] = *(const v4u*)(_p + 9216 + g * 128 + sseg * 32 + 8 * k); } \
        rx[0] = *(const v4u*)(_p + head * 64 + sseg * 16); rx[1] = *(const v4u*)(_p + head * 64 + sseg * 16 + 8); \
        if (w == 0) { rd0 = DT[(size_t)(_b + e0) * 256 + dir * 128 + head]; rd1 = DT[(size_t)(_b + e1) * 256 + dir * 128 + head]; } } while (0)
#define SSD_SCAN(jb) do { LAS float* _c = (LAS float*)(lds + SS_CUM + (jb) * 2048); const float v0 = rd0 * a, v1 = rd1 * a; float inc = v0 + v1; \
        _Pragma("unroll") for (int o = 1; o < 64; o <<= 1) { const float t = __shfl_up(inc, o); if (lane >= o) inc += t; } \
        const float c0 = inc - v1, c1 = inc; const float total = __shfl(inc, 63); \
        _c[e0] = c0; _c[e1] = c1; _c[128 + e0] = rd0; _c[128 + e1] = rd1; _c[256 + e0] = rd0 * __expf(total - c0); _c[256 + e1] = rd1 * __expf(total - c1); \
        if (lane == 0) _c[384] = total; } while (0)
        SSD_LOAD(0);
        if (w == 0) SSD_SCAN(0);
        for (int j = 0; j < 66; ++j) {
            const int base = ssd_chunk_base(dir, j);
            LAS float* cum = (LAS float*)(lds + SS_CUM + (j & 1) * 2048); LAS float* dtv = cum + 128; LAS float* wv = cum + 256; LAS float* tot = cum + 384;
            __syncthreads();
#pragma unroll
            for (int pt = 0; pt < 4; ++pt) { v2u hp; hp.x = pk2(Hm[pt][0], Hm[pt][1]); hp.y = pk2(Hm[pt][2], Hm[pt][3]);
                *(LAS v2u*)(lds + SS_HT + (16 * wq + i) * SS_RX + (16 * pt + 4 * q) * 2) = hp; }
            { const float wl = wv[srow];
#pragma unroll
              for (int k = 0; k < 4; ++k) { *(LAS v4u*)(lds + SS_BT + srow * SS_RS + (sseg * 32 + 8 * k) * 2) = rb[k]; *(LAS v4u*)(lds + SS_CT + srow * SS_RS + (sseg * 32 + 8 * k) * 2) = rc[k];
                  v4u bw;
#pragma unroll
                  for (int e = 0; e < 4; ++e) bw[e] = pk2(bflo(rb[k][e]) * wl, bfhi(rb[k][e]) * wl);
                  *(LAS v4u*)(lds + SS_BW + srow * SS_RS + (sseg * 32 + 8 * k) * 2) = bw; } }
            *(LAS v4u*)(lds + SS_XN + srow * SS_RX + (sseg * 16) * 2) = rx[0]; *(LAS v4u*)(lds + SS_XN + srow * SS_RX + (sseg * 16 + 8) * 2) = rx[1];
            __syncthreads();
            if (j + 1 < 66) SSD_LOAD(j + 1);
            bf16x8_t cf[4];
#pragma unroll
            for (int kk = 0; kk < 4; ++kk) cf[kk] = *(const LAS bf16x8_t*)(lds + SS_CT + (16 * wq + i) * SS_RS + (32 * kk + 8 * q) * 2);
            const float cl = cum[16 * wq + i];
            f32x4 accd[4], acco[4];
#pragma unroll
            for (int pt = 0; pt < 4; ++pt) { accd[pt] = (f32x4){0.f, 0.f, 0.f, 0.f}; acco[pt] = (f32x4){0.f, 0.f, 0.f, 0.f}; }
#pragma unroll
            for (int ks = 0; ks < 4; ++ks) {
                const int st0 = 2 * ks, st1 = 2 * ks + 1;
                const bool need0 = dir ? (st0 >= w) : (st0 <= w), need1 = dir ? (st1 >= w) : (st1 <= w);
                if (!need0 && !need1) continue;
                v2u xa[4], xc[4];
#pragma unroll
                for (int pt = 0; pt < 4; ++pt) { xa[pt] = tr_read8_dyn(trb_x4, 32 * ks * SS_RX + 32 * pt); xc[pt] = tr_read8_dyn(trb_x4, (32 * ks + 16) * SS_RX + 32 * pt); }
                f32x4 g0 = (f32x4){0.f, 0.f, 0.f, 0.f}, g1 = (f32x4){0.f, 0.f, 0.f, 0.f};
                if (need0) {
#pragma unroll
                    for (int kk = 0; kk < 4; ++kk) { const bf16x8_t ab = *(const LAS bf16x8_t*)(lds + SS_BT + (16 * st0 + i) * SS_RS + (32 * kk + 8 * q) * 2); g0 = __builtin_amdgcn_mfma_f32_16x16x32_bf16(ab, cf[kk], g0, 0, 0, 0); }
                    const f32x4 cs = *(const LAS f32x4*)(cum + 16 * st0 + 4 * q), ds = *(const LAS f32x4*)(dtv + 16 * st0 + 4 * q);
                    if (st0 == w) {
#pragma unroll
                        for (int r = 0; r < 4; ++r) g0[r] = g0[r] * __expf(cl - cs[r] + pen[r]) * ds[r];
                    } else {
#pragma unroll
                        for (int r = 0; r < 4; ++r) g0[r] = g0[r] * __expf(cl - cs[r]) * ds[r];
                    }
                }
                if (need1) {
#pragma unroll
                    for (int kk = 0; kk < 4; ++kk) { const bf16x8_t ab = *(const LAS bf16x8_t*)(lds + SS_BT + (16 * st1 + i) * SS_RS + (32 * kk + 8 * q) * 2); g1 = __builtin_amdgcn_mfma_f32_16x16x32_bf16(ab, cf[kk], g1, 0, 0, 0); }
                    const f32x4 cs = *(const LAS f32x4*)(cum + 16 * st1 + 4 * q), ds = *(const LAS f32x4*)(dtv + 16 * st1 + 4 * q);
                    if (st1 == w) {
#pragma unroll
                        for (int r = 0; r < 4; ++r) g1[r] = g1[r] * __expf(cl - cs[r] + pen[r]) * ds[r];
                    } else {
#pragma unroll
                        for (int r = 0; r < 4; ++r) g1[r] = g1[r] * __expf(cl - cs[r]) * ds[r];
                    }
                }
                v4u amw; amw.x = pk2(g0[0], g0[1]); amw.y = pk2(g0[2], g0[3]); amw.z = pk2(g1[0], g1[1]); amw.w = pk2(g1[2], g1[3]);
                const bf16x8_t am = __builtin_bit_cast(bf16x8_t, amw);
                SS_LGKM_WAIT();
#pragma unroll
                for (int pt = 0; pt < 4; ++pt) { v4u xb; xb.x = xa[pt].x; xb.y = xa[pt].y; xb.z = xc[pt].x; xb.w = xc[pt].y;
                    accd[pt] = __builtin_amdgcn_mfma_f32_16x16x32_bf16(am, __builtin_bit_cast(bf16x8_t, xb), accd[pt], 0, 0, 0); }
            }
#pragma unroll
            for (int kh = 0; kh < 2; ++kh) { v2u h0[2][4], h1[2][4];
#pragma unroll
              for (int k2 = 0; k2 < 2; ++k2)
#pragma unroll
                  for (int pt = 0; pt < 4; ++pt) { h0[k2][pt] = tr_read8_dyn(trb_h8, 32 * (2 * kh + k2) * SS_RX + 32 * pt); h1[k2][pt] = tr_read8_dyn(trb_h8, (32 * (2 * kh + k2) + 4) * SS_RX + 32 * pt); }
              SS_LGKM_WAIT();
#pragma unroll
              for (int k2 = 0; k2 < 2; ++k2)
#pragma unroll
                  for (int pt = 0; pt < 4; ++pt) { v4u hb; hb.x = h0[k2][pt].x; hb.y = h0[k2][pt].y; hb.z = h1[k2][pt].x; hb.w = h1[k2][pt].y;
                      acco[pt] = __builtin_amdgcn_mfma_f32_16x16x32_bf16(cf[2 * kh + k2], __builtin_bit_cast(bf16x8_t, hb), acco[pt], 0, 0, 0); } }
            { const f32x4 c4 = *(const LAS f32x4*)(cum + 16 * wq + 4 * q); float ev[4];
#pragma unroll
              for (int r = 0; r < 4; ++r) ev[r] = __expf(c4[r]);
              if (dir == 0) {
#pragma unroll
                for (int pt = 0; pt < 4; ++pt)
#pragma unroll
                  for (int r = 0; r < 4; ++r) accd[pt][r] += dsk * bf2f(*(const LAS bf16*)(lds + SS_XN + (16 * wq + 4 * q + r) * SS_RX + (16 * pt + i) * 2));
              }
#pragma unroll
              for (int pt = 0; pt < 4; ++pt)
#pragma unroll
                  for (int r = 0; r < 4; ++r) Y[(size_t)(base + 16 * wq + 4 * q + r) * 8192 + head * 64 + 16 * pt + i] = (bf16)(pk2(accd[pt][r] + ev[r] * acco[pt][r], 0.f) & 0xffffu); }
            { const float sc = __expf(tot[0]);
#pragma unroll
              for (int pt = 0; pt < 4; ++pt) Hm[pt] = Hm[pt] * sc;
#pragma unroll
              for (int kh = 0; kh < 2; ++kh) {
                  v2u b0[2], b1[2], x0[2][4], x1[2][4];
#pragma unroll
                  for (int k2 = 0; k2 < 2; ++k2) { const int kk = 2 * kh + k2;
                      b0[k2] = tr_read8_dyn(trb_b8, 32 * kk * SS_RS); b1[k2] = tr_read8_dyn(trb_b8, (32 * kk + 4) * SS_RS);
#pragma unroll
                      for (int pt = 0; pt < 4; ++pt) { x0[k2][pt] = tr_read8_dyn(trb_x8, 32 * kk * SS_RX + 32 * pt); x1[k2][pt] = tr_read8_dyn(trb_x8, (32 * kk + 4) * SS_RX + 32 * pt); } }
                  SS_LGKM_WAIT();
#pragma unroll
                  for (int k2 = 0; k2 < 2; ++k2) { v4u bb; bb.x = b0[k2].x; bb.y = b0[k2].y; bb.z = b1[k2].x; bb.w = b1[k2].y;
#pragma unroll
                      for (int pt = 0; pt < 4; ++pt) { v4u xx; xx.x = x0[k2][pt].x; xx.y = x0[k2][pt].y; xx.z = x1[k2][pt].x; xx.w = x1[k2][pt].y;
                          Hm[pt] = __builtin_amdgcn_mfma_f32_16x16x32_bf16(__builtin_bit_cast(bf16x8_t, xx), __builtin_bit_cast(bf16x8_t, bb), Hm[pt], 0, 0, 0); } } } }
            if (w == 0 && j + 1 < 66) SSD_SCAN((j + 1) & 1);
        }
#undef SSD_LOAD
#undef SSD_SCAN
        __syncthreads();
    }
}

__device__ __forceinline__ void ssd_finish_phase(const bf16* YF, const bf16* YB, const bf16* ZX, const float* norm_w, bf16* A2, int gw, int NGW, int lane) {
    f32x4 nwr[2][2]; int g_have = -1;
    for (int it = gw; it < TT * 8; it += NGW) {
        const int r = it >> 3, g = it & 7;
        if (g != g_have) { g_have = g;
#pragma unroll
            for (int j = 0; j < 2; ++j) { const int c = g * 1024 + 8 * (lane + 64 * j); nwr[j][0] = *(const f32x4*)(norm_w + c); nwr[j][1] = *(const f32x4*)(norm_w + c + 4); } }
        v4u yfp[2], ybp[2], zp[2];
#pragma unroll
        for (int j = 0; j < 2; ++j) { const int c = g * 1024 + 8 * (lane + 64 * j);
            yfp[j] = *(const v4u*)(YF + (size_t)r * 8192 + c); ybp[j] = *(const v4u*)(YB + (size_t)r * 8192 + c); zp[j] = *(const v4u*)(ZX + (size_t)r * SSD_ZXW + c); }
        float y[2][8]; float ss = 0.f;
#pragma unroll
        for (int j = 0; j < 2; ++j)
#pragma unroll
            for (int e = 0; e < 4; ++e) {
                const float v0 = (bflo(yfp[j][e]) + bflo(ybp[j][e])) * silu_f(bflo(zp[j][e])), v1 = (bfhi(yfp[j][e]) + bfhi(ybp[j][e])) * silu_f(bfhi(zp[j][e]));
                y[j][2 * e] = v0; y[j][2 * e + 1] = v1; ss += v0 * v0 + v1 * v1; }
        ss = wave_sum(ss); const float rs = rsqrtf(ss * (1.f / 1024.f) + RMS_EPS);
#pragma unroll
        for (int j = 0; j < 2; ++j) { const int c = g * 1024 + 8 * (lane + 64 * j); const f32x4 n0 = nwr[j][0], n1 = nwr[j][1];
            v4u w; w.x = pk2(y[j][0] * rs * n0.x, y[j][1] * rs * n0.y); w.y = pk2(y[j][2] * rs * n0.z, y[j][3] * rs * n0.w);
            w.z = pk2(y[j][4] * rs * n1.x, y[j][5] * rs * n1.y); w.w = pk2(y[j][6] * rs * n1.z, y[j][7] * rs * n1.w);
            *(v4u*)(A2 + (size_t)r * 8192 + c) = w; }
    }
}

constexpr int S5_POW = 0, S5_C = 17408, S5_BB = 33792, S5_A16 = 50176, S5_SCB = 51200, S5_HSB = 101376, S5_KL = 51200, S5_END = 125952;
static_assert(S5_END <= LDSCTL_OFF, "S5 LDS map");
__device__ __forceinline__ int s5_tile_of(int half, int k) { return half ? (k == 0 ? 0 : 33 - k) : k; }
__device__ __forceinline__ void s5_mixer_phase(const bf16* H, const float* lam_re, const float* lam_im, const float* log_step, const float* b_re, const float* b_im,
                                               const float* c_re, const float* c_im, const float* d_skip, bf16* HSG, bf16* A5, LAS unsigned char* lds, int tid) {
    LAS float* POW = (LAS float*)(lds + S5_POW); LAS float* CT = (LAS float*)(lds + S5_C); LAS float* BB = (LAS float*)(lds + S5_BB); LAS float* A16 = (LAS float*)(lds + S5_A16);
    LAS float* SCB = (LAS float*)(lds + S5_SCB); LAS bf16* HSB = (LAS bf16*)(lds + S5_HSB); LAS float* KL = (LAS float*)(lds + S5_KL);
    for (int g = blockIdx.x; g < 256; g += gridDim.x) {
        int tq = tid; asm volatile("" : "+v"(tq));
        const int lane = tq & 63, w = __builtin_amdgcn_readfirstlane(tq >> 6), wq = tq >> 6, i = lane & 15, q = lane >> 4;
        __syncthreads();
        if (tid < 128) { const int d = tid >> 6, p = tid & 63;
            const float step = __expf(log_step[d * 256 + g]); const float lr = lam_re[(size_t)(d * 256 + g) * 64 + p], li = lam_im[(size_t)(d * 256 + g) * 64 + p];
            const float mag = expf(lr * step), ar = mag * cosf(li * step), ai = mag * sinf(li * step);
            const float den = lr * lr + li * li, kr = ((ar - 1.f) * lr + ai * li) / den, ki = (ai * lr - (ar - 1.f) * li) / den;
            float pr = 1.f, pi = 0.f;
            for (int e = 0; e <= 16; ++e) { POW[((d * 17 + e) * 64 + p) * 2] = pr; POW[((d * 17 + e) * 64 + p) * 2 + 1] = pi; const float nr = pr * ar - pi * ai, ni = pr * ai + pi * ar; pr = nr; pi = ni; }
            A16[(d * 64 + p) * 2] = POW[((d * 17 + 16) * 64 + p) * 2]; A16[(d * 64 + p) * 2 + 1] = POW[((d * 17 + 16) * 64 + p) * 2 + 1];
            for (int c = 0; c < 16; ++c) { const float br = b_re[(size_t)(g * 64 + p) * 16 + c], bi = b_im[(size_t)(g * 64 + p) * 16 + c];
                BB[((d * 64 + p) * 16 + c) * 2] = kr * br - ki * bi; BB[((d * 64 + p) * 16 + c) * 2 + 1] = kr * bi + ki * br; } }
        for (int idx = tid; idx < 2048; idx += NWAVES * 64) { const int d = idx >> 10, c = (idx >> 6) & 15, p = idx & 63;
            CT[idx * 2] = c_re[((size_t)(d * 256 + g) * 16 + c) * 64 + p]; CT[idx * 2 + 1] = c_im[((size_t)(d * 256 + g) * 16 + c) * 64 + p]; }
        __syncthreads();
        const int half = w >> 2, reim = (w >> 1) & 1;
        {
            bf16x8_t sa[2][8];
#pragma unroll
            for (int t2 = 0; t2 < 2; ++t2) { const int p = 32 * (w & 1) + 16 * t2 + i;
#pragma unroll
                for (int kk = 0; kk < 8; ++kk) { const int sT = 2 * kk + (q >> 1), e = half ? sT : 15 - sT;
                    const float pr = POW[((half * 17 + e) * 64 + p) * 2], pi = POW[((half * 17 + e) * 64 + p) * 2 + 1];
                    float v[8];
#pragma unroll
                    for (int j = 0; j < 8; ++j) { const float br = BB[((half * 64 + p) * 16 + 8 * (q & 1) + j) * 2], bi = BB[((half * 64 + p) * 16 + 8 * (q & 1) + j) * 2 + 1]; v[j] = reim ? (pr * bi + pi * br) : (pr * br - pi * bi); }
                    v4u pk; pk.x = pk2(v[0], v[1]); pk.y = pk2(v[2], v[3]); pk.z = pk2(v[4], v[5]); pk.w = pk2(v[6], v[7]); sa[t2][kk] = __builtin_bit_cast(bf16x8_t, pk); __builtin_amdgcn_sched_barrier(0); } }
            float hr = 0.f, hi = 0.f;
#pragma unroll 1
            for (int b = 0; b < 11; ++b) {
#pragma unroll 1
                for (int sl = 0; sl < 3; ++sl) { const int nt = s5_tile_of(half, 3 * b + sl);
                    bf16x8_t ub[8];
#pragma unroll
                    for (int kk = 0; kk < 8; ++kk) ub[kk] = *(const bf16x8_t*)(H + (size_t)(256 * nt + 16 * i + 2 * kk + (q >> 1)) * DM + 16 * g + 8 * (q & 1));
#pragma unroll
                    for (int t2 = 0; t2 < 2; ++t2) { f32x4 acc = {0.f, 0.f, 0.f, 0.f};
#pragma unroll
                        for (int kk = 0; kk < 8; ++kk) acc = __builtin_amdgcn_mfma_f32_16x16x32_bf16(sa[t2][kk], ub[kk], acc, 0, 0, 0);
#pragma unroll
                        for (int r = 0; r < 4; ++r) SCB[(32 * wq + 16 * t2 + 4 * q + r) * 49 + 16 * sl + i] = acc[r]; } }
                __syncthreads();
                if (tid < 128) { const int d = tid >> 6, p = tid & 63; const float ar16 = A16[(d * 64 + p) * 2], ai16 = A16[(d * 64 + p) * 2 + 1];
                    const LAS float* sre = SCB + (d * 128 + p) * 49; const LAS float* sim = SCB + (d * 128 + 64 + p) * 49;
#pragma unroll 2
                    for (int pos = 0; pos < 48; ++pos) { const int col = d ? (16 * (pos >> 4) + 15 - (pos & 15)) : pos;
                        HSB[(d * 48 + col) * 128 + p] = (bf16)(pk2(hr, 0.f) & 0xffffu); HSB[(d * 48 + col) * 128 + 64 + p] = (bf16)(pk2(hi, 0.f) & 0xffffu);
                        const float nr = ar16 * hr - ai16 * hi + sre[col], ni = ar16 * hi + ai16 * hr + sim[col]; hr = nr; hi = ni; } }
                __syncthreads();
                for (int idx = tid; idx < 1536; idx += NWAVES * 64) { const int d = idx / 768, rem = idx % 768, col = rem >> 4, pc = rem & 15;
                    const int chunk = 16 * s5_tile_of(d, 3 * b + (col >> 4)) + (col & 15);
                    *(v4u*)(HSG + ((size_t)(g * 528 + chunk) * 256 + d * 128 + 8 * pc)) = *(const LAS v4u*)(HSB + (d * 48 + col) * 128 + 8 * pc); }
            }
        }
        asm volatile("s_waitcnt vmcnt(0)" ::: "memory");
        __syncthreads();
        { const int d = tid >> 8, lag = (tid >> 4) & 15, c = tid & 15; float acc[16];
#pragma unroll
          for (int cc = 0; cc < 16; ++cc) acc[cc] = 0.f;
          for (int p = 0; p < 64; ++p) { const float cr = CT[((d * 16 + c) * 64 + p) * 2], ci = CT[((d * 16 + c) * 64 + p) * 2 + 1], pr = POW[((d * 17 + lag) * 64 + p) * 2], pi = POW[((d * 17 + lag) * 64 + p) * 2 + 1];
              const float xr = cr * pr - ci * pi, xi = cr * pi + ci * pr;
#pragma unroll
              for (int cc = 0; cc < 16; ++cc) acc[cc] += xr * BB[((d * 64 + p) * 16 + cc) * 2] - xi * BB[((d * 64 + p) * 16 + cc) * 2 + 1]; }
#pragma unroll
          for (int cc = 0; cc < 16; ++cc) KL[((d * 16 + lag) * 16 + c) * 16 + cc] = acc[cc]; }
        __syncthreads();
        {
            bf16x8_t tf[2][8], wf[2][8];
#pragma unroll
            for (int t2 = 0; t2 < 2; ++t2) { const int l = 2 * wq + t2;
#pragma unroll
                for (int kk = 0; kk < 8; ++kk) { const int sT = 2 * kk + (q >> 1); float v[8];
#pragma unroll
                    for (int j = 0; j < 8; ++j) { const int cc = 8 * (q & 1) + j;
                        const int dl = sT - l, dsel = dl > 0 ? 1 : 0, lag = dl > 0 ? dl : -dl;
                        v[j] = KL[((dsel * 16 + lag) * 16 + i) * 16 + cc] + (dl == 0 ? KL[((16 + 0) * 16 + i) * 16 + cc] : 0.f); }
                    v4u pk; pk.x = pk2(v[0], v[1]); pk.y = pk2(v[2], v[3]); pk.z = pk2(v[4], v[5]); pk.w = pk2(v[6], v[7]); tf[t2][kk] = __builtin_bit_cast(bf16x8_t, pk); __builtin_amdgcn_sched_barrier(0); }
#pragma unroll
                for (int kk = 0; kk < 8; ++kk) { const int d = kk >> 2, ri = (kk >> 1) & 1, e = d ? 16 - l : l + 1; float v[8];
#pragma unroll
                    for (int j = 0; j < 8; ++j) { const int p = 32 * (kk & 1) + 8 * q + j;
                        const float cr = CT[((d * 16 + i) * 64 + p) * 2], ci = CT[((d * 16 + i) * 64 + p) * 2 + 1], pr = POW[((d * 17 + e) * 64 + p) * 2], pi = POW[((d * 17 + e) * 64 + p) * 2 + 1];
                        v[j] = ri ? -(cr * pi + ci * pr) : (cr * pr - ci * pi); }
                    v4u pk; pk.x = pk2(v[0], v[1]); pk.y = pk2(v[2], v[3]); pk.z = pk2(v[4], v[5]); pk.w = pk2(v[6], v[7]); wf[t2][kk] = __builtin_bit_cast(bf16x8_t, pk); __builtin_amdgcn_sched_barrier(0); } }
            const f32x4 d4 = *(const f32x4*)(d_skip + 16 * g + 4 * q);
#pragma unroll 1
            for (int nt = 0; nt < 33; ++nt) {
                bf16x8_t ub[8], hb[8];
#pragma unroll
                for (int kk = 0; kk < 8; ++kk) { ub[kk] = *(const bf16x8_t*)(H + (size_t)(256 * nt + 16 * i + 2 * kk + (q >> 1)) * DM + 16 * g + 8 * (q & 1));
                    hb[kk] = *(const bf16x8_t*)(HSG + ((size_t)(g * 528 + 16 * nt + i) * 256 + 32 * kk + 8 * q)); }
#pragma unroll
                for (int t2 = 0; t2 < 2; ++t2) { f32x4 acc = {0.f, 0.f, 0.f, 0.f};
#pragma unroll
                    for (int kk = 0; kk < 8; ++kk) { acc = __builtin_amdgcn_mfma_f32_16x16x32_bf16(tf[t2][kk], ub[kk], acc, 0, 0, 0); acc = __builtin_amdgcn_mfma_f32_16x16x32_bf16(wf[t2][kk], hb[kk], acc, 0, 0, 0); }
                    const size_t off = (size_t)(256 * nt + 16 * i + 2 * wq + t2) * DM + 16 * g + 4 * q;
                    const v2u uu = *(const v2u*)(H + off);
                    const float y0 = acc[0] + d4.x * bflo(uu.x), y1 = acc[1] + d4.y * bfhi(uu.x), y2 = acc[2] + d4.z * bflo(uu.y), y3 = acc[3] + d4.w * bfhi(uu.y);
                    v2u o; o.x = pk2(gelu_tanh_f(y0), gelu_tanh_f(y1)); o.y = pk2(gelu_tanh_f(y2), gelu_tanh_f(y3));
                    *(v2u*)(A5 + off) = o; }
            }
        }
    }
}
__device__ __forceinline__ void s5_glu_phase(const bf16* Z, const float* modL, int g_off, float* X, int gtid, int NT) {
    const size_t n4 = (size_t)TT * DM / 4;
    for (size_t i = gtid; i < n4; i += NT) { const size_t e = i * 4; const int r = (int)(e >> 12), c = (int)(e & (DM - 1));
        const v2u za = *(const v2u*)(Z + (size_t)r * 8192 + c), zg = *(const v2u*)(Z + (size_t)r * 8192 + 4096 + c);
        const f32x4 gt = *(const f32x4*)(modL + (r < TC ? MODW : 0) + g_off + c);
        f32x4 xv = *(const f32x4*)(X + e);
        xv.x += gt.x * bflo(za.x) * sigmoid_f(bflo(zg.x)); xv.y += gt.y * bfhi(za.x) * sigmoid_f(bfhi(zg.x));
        xv.z += gt.z * bflo(za.y) * sigmoid_f(bflo(zg.y)); xv.w += gt.w * bfhi(za.y) * sigmoid_f(bfhi(zg.y));
        *(f32x4*)(X + e) = xv; }
}

__device__ __forceinline__ void s5_glu_norm_phase(const bf16* __restrict__ Z, const float* __restrict__ modL, bf16* __restrict__ X, const float* __restrict__ gain, bf16* __restrict__ H, int gw, int NGW, int lane) {
    for (int r = gw; r < TT; r += NGW) {
        bf16* xr = X + (size_t)r * DM; const bf16* zr = Z + (size_t)r * 8192; const float* md = modL + (r < TC ? MODW : 0);
        f32x4 v[16]; float ss = 0.f;
#pragma unroll
        for (int j = 0; j < 16; ++j) { const int c = 4 * (lane + 64 * j);
            const v2u xb = *(const v2u*)(xr + c); const f32x4 x = {bflo(xb.x), bfhi(xb.x), bflo(xb.y), bfhi(xb.y)}, gt = *(const f32x4*)(md + 8192 + c); const v2u za = *(const v2u*)(zr + c), zg = *(const v2u*)(zr + 4096 + c);
            f32x4 o; o.x = x.x + gt.x * bflo(za.x) * sigmoid_f(bflo(zg.x)); o.y = x.y + gt.y * bfhi(za.x) * sigmoid_f(bfhi(zg.x));
            o.z = x.z + gt.z * bflo(za.y) * sigmoid_f(bflo(zg.y)); o.w = x.w + gt.w * bfhi(za.y) * sigmoid_f(bfhi(zg.y));
            v[j] = o; ss += (o.x * o.x + o.y * o.y) + (o.z * o.z + o.w * o.w); v2u xo; xo.x = pk2(o.x, o.y); xo.y = pk2(o.z, o.w); *(v2u*)(xr + c) = xo; }
        ss = wave_sum(ss); const float rs = rsqrtf(ss * (1.f / DM) + RMS_EPS);
#pragma unroll
        for (int j = 0; j < 16; ++j) { const int c = 4 * (lane + 64 * j);
            const f32x4 g = *(const f32x4*)(gain + c), sc = *(const f32x4*)(md + 16384 + c), sh = *(const f32x4*)(md + 12288 + c);
            const f32x4 o = (v[j] * rs) * g * (sc + 1.f) + sh;
            v2u w; w.x = pk2(o.x, o.y); w.y = pk2(o.z, o.w); *(v2u*)(H + (size_t)r * DM + c) = w; }
    }
}

__device__ __forceinline__ void da_qknorm_phase(bf16* QKV, const float* q_gain, const float* k_gain, const float* ROPE, unsigned* kmax_bits, int gw, int NGW, int lane) {
    float kmx = 0.f;
    const int k16 = lane & 15, half = k16 >> 3, kk = k16 & 7, el = 8 * k16;
    const bool first = kk < 4;
    constexpr int QU = 6;
    f32x4 g0 = {0.f, 0.f, 0.f, 0.f}, g1 = {0.f, 0.f, 0.f, 0.f}; int hq_have = -1;
    for (int it0 = gw; it0 < TT * 16; it0 += QU * NGW) {
        v4u rawq[QU];
#pragma unroll
        for (int u = 0; u < QU; ++u) rawq[u] = (v4u){0u, 0u, 0u, 0u};
        if (it0 + (QU - 1) * NGW < TT * 16) {
#pragma unroll
            for (int u = 0; u < QU; ++u) { const int it = it0 + u * NGW; rawq[u] = *(const v4u*)(QKV + (size_t)(it >> 4) * 12288 + (4 * (it & 15) + (lane >> 4)) * 128 + el); }
        } else {
#pragma unroll
            for (int u = 0; u < QU; ++u) { const int it = it0 + u * NGW; if (it < TT * 16) rawq[u] = *(const v4u*)(QKV + (size_t)(it >> 4) * 12288 + (4 * (it & 15) + (lane >> 4)) * 128 + el); } }
        asm volatile("" ::: "memory");
#pragma unroll
        for (int u = 0; u < QU; ++u) { const int it = it0 + u * NGW; if (it >= TT * 16) break;
        const int r = it >> 4, hq = it & 15; const int hh = 4 * hq + (lane >> 4);
        bf16* px = QKV + (size_t)r * 12288 + hh * 128 + el;
        const v4u raw = rawq[u];
        float x[8];
#pragma unroll
        for (int e = 0; e < 4; ++e) { x[2 * e] = bflo(raw[e]); x[2 * e + 1] = bfhi(raw[e]); }
        float ss = 0.f;
#pragma unroll
        for (int e = 0; e < 8; ++e) ss += x[e] * x[e];
        ss += __shfl_xor(ss, 1); ss += __shfl_xor(ss, 2); ss += __shfl_xor(ss, 4); ss += __shfl_xor(ss, 8);
        const float rs = rsqrtf(ss * (1.f / 128.f) + RMS_EPS);
        if (hq != hq_have) { hq_have = hq; const float* gn = (hh < 32 ? q_gain : k_gain) + el; g0 = *(const f32x4*)gn; g1 = *(const f32x4*)(gn + 4); }
        float y[8];
        y[0] = x[0] * rs * g0.x; y[1] = x[1] * rs * g0.y; y[2] = x[2] * rs * g0.z; y[3] = x[3] * rs * g0.w; y[4] = x[4] * rs * g1.x; y[5] = x[5] * rs * g1.y; y[6] = x[6] * rs * g1.z; y[7] = x[7] * rs * g1.w;
        float pv[8];
#pragma unroll
        for (int e = 0; e < 8; ++e) pv[e] = __shfl_xor(y[e], 4);
        if (r >= TC) { const int t = r - TC; const int pos = half ? (t & 63) : (t >> 6);
            const float* cs = ROPE + ((size_t)pos * 32 + 8 * (kk & 3)) * 2;
#pragma unroll
            for (int e = 0; e < 4; ++e) { const f32x4 c2 = *(const f32x4*)(cs + 4 * e);
                const float a0 = y[2 * e], a1 = y[2 * e + 1], b0 = pv[2 * e], b1 = pv[2 * e + 1];
                y[2 * e] = first ? (a0 * c2.x - b0 * c2.y) : (b0 * c2.y + a0 * c2.x);
                y[2 * e + 1] = first ? (a1 * c2.z - b1 * c2.w) : (b1 * c2.w + a1 * c2.z); } }
        v4u o; o.x = pk2(y[0], y[1]); o.y = pk2(y[2], y[3]); o.z = pk2(y[4], y[5]); o.w = pk2(y[6], y[7]);
        *(v4u*)px = o;
        { float s2 = 0.f;
#pragma unroll
          for (int e = 0; e < 8; ++e) s2 += y[e] * y[e];
          s2 += __shfl_xor(s2, 1); s2 += __shfl_xor(s2, 2); s2 += __shfl_xor(s2, 4); s2 += __shfl_xor(s2, 8); kmx = fmaxf(kmx, s2); }
    }
    }
    if ((NGW & 15) == 0) { const int hh = 4 * (gw & 15) + (lane >> 4); if (hh >= 32 && (lane & 15) == 0 && gw < TT * 16) atomicMax(kmax_bits + (hh - 32), __float_as_uint(kmx)); }
}
__device__ __forceinline__ void da_combine_phase(const float* O, const float* lq1, const float* lk1, const float* lq2, const float* lk2, const float* sub_gain, float lambda_init, bf16* AO, int gw, int NGW, int lane) {
    const float s1 = wave_sum(lq1[lane] * lk1[lane] + lq1[lane + 64] * lk1[lane + 64]), s2 = wave_sum(lq2[lane] * lk2[lane] + lq2[lane + 64] * lk2[lane + 64]);
    const float lam = expf(s1) - expf(s2) + lambda_init;
    const f32x4 sg = *(const f32x4*)(sub_gain + 4 * lane);
    constexpr int CU_ = 6;
    for (int it0 = gw; it0 < TT * 16; it0 += CU_ * NGW) {
        f32x4 a1[CU_], a2[CU_];
#pragma unroll
        for (int u = 0; u < CU_; ++u) { const int it = it0 + u * NGW; const bool ok = it < TT * 16; const float* po = O + (size_t)(it >> 4) * 8192 + (it & 15) * 256 + 4 * lane;
            a1[u] = ok ? *(const f32x4*)po : (f32x4){0.f, 0.f, 0.f, 0.f}; a2[u] = ok ? *(const f32x4*)(po + 4096) : (f32x4){0.f, 0.f, 0.f, 0.f}; }
        asm volatile("" ::: "memory");
#pragma unroll
        for (int u = 0; u < CU_; ++u) { const int it = it0 + u * NGW; if (it >= TT * 16) break;
            const int r = it >> 4, hd = it & 15;
            const f32x4 o = a1[u] - a2[u] * lam;
            const float ss = wave_sum((o.x * o.x + o.y * o.y) + (o.z * o.z + o.w * o.w)); const float rs = rsqrtf(ss * (1.f / 256.f) + RMS_EPS) * (1.f - lambda_init);
            const f32x4 w = o * rs * sg; v2u pk; pk.x = pk2(w.x, w.y); pk.y = pk2(w.z, w.w);
            *(v2u*)(AO + (size_t)r * 4096 + hd * 256 + 4 * lane) = pk; }
    }
}

struct CtxStore { bf16* O; int ldc; const float* bias;
    __device__ __forceinline__ void operator()(int row, int col, f32x4 lo, f32x4 hi) const {
        if (bias) { lo = lo + *(const f32x4*)(bias + col); hi = hi + *(const f32x4*)(bias + col + 4); }
        v4u w; w.x = pk2(lo.x, lo.y); w.y = pk2(lo.z, lo.w); w.z = pk2(hi.x, hi.y); w.w = pk2(hi.z, hi.w); *(v4u*)(O + (size_t)row * ldc + col) = w; } };
struct CtxResid { bf16* X; const float* gate; const float* Xrd;
    __device__ __forceinline__ void operator()(int row, int col, f32x4 lo, f32x4 hi) const {
        bf16* p = X + (size_t)row * 4096 + col; const f32x4 g0 = *(const f32x4*)(gate + col), g1 = *(const f32x4*)(gate + col + 4);
        f32x4 x0, x1;
        if (Xrd) { const float* pr = Xrd + (size_t)row * 4096 + col; x0 = *(const f32x4*)pr; x1 = *(const f32x4*)(pr + 4); }
        else { const v4u xb = *(const v4u*)p; x0 = f32x4{bflo(xb.x), bfhi(xb.x), bflo(xb.y), bfhi(xb.y)}; x1 = f32x4{bflo(xb.z), bfhi(xb.z), bflo(xb.w), bfhi(xb.w)}; }
        const f32x4 o0 = x0 + g0 * lo, o1 = x1 + g1 * hi;
        v4u w; w.x = pk2(o0.x, o0.y); w.y = pk2(o0.z, o0.w); w.z = pk2(o1.x, o1.y); w.w = pk2(o1.z, o1.w); *(v4u*)p = w; } };
template <class CE>
__device__ __forceinline__ void ctx_gemm(const bf16* A, const bf16* Bt, int N, int K, const CE& E, LAS unsigned char* lds, int tid, int vcu, int G) {
    int tq = tid; asm volatile("" : "+v"(tq));
    const int lane = tq & 63, wq = tq >> 6, i = lane & 15, q = lane >> 4;
    const int ksl = K >> 3;
    LAS float* RED = (LAS float*)lds;
    for (int t = vcu; t < 4 * (N >> 6); t += G) {
        const int rb = t & 3, nb = t >> 2;
        f32x4 acc[4][4];
#pragma unroll
        for (int m = 0; m < 4; ++m)
#pragma unroll
            for (int n = 0; n < 4; ++n) acc[m][n] = (f32x4){0.f, 0.f, 0.f, 0.f};
        const bf16* Ap = A + (size_t)(64 * rb + i) * K + wq * ksl + 8 * q;
        const bf16* Bp = Bt + (size_t)(64 * nb + i) * K + wq * ksl + 8 * q;
        bf16x8_t fa0[2][4], fb0[2][4], fa1[2][4], fb1[2][4];
#define CG_LOAD(FA, FB, ks0) do { _Pragma("unroll") for (int s2 = 0; s2 < 2; ++s2) _Pragma("unroll") for (int m = 0; m < 4; ++m) { \
            FA[s2][m] = *(const bf16x8_t*)(Ap + (size_t)(16 * m) * K + 32 * ((ks0) + s2)); FB[s2][m] = *(const bf16x8_t*)(Bp + (size_t)(16 * m) * K + 32 * ((ks0) + s2)); } } while (0)
#define CG_MMA(FA, FB) do { _Pragma("unroll") for (int s2 = 0; s2 < 2; ++s2) _Pragma("unroll") for (int m = 0; m < 4; ++m) _Pragma("unroll") for (int n = 0; n < 4; ++n) \
            acc[m][n] = __builtin_amdgcn_mfma_f32_16x16x32_bf16(FB[s2][n], FA[s2][m], acc[m][n], 0, 0, 0); } while (0)
        const int npair = ksl >> 6;
        CG_LOAD(fa0, fb0, 0);
        for (int pr = 0; pr < npair; pr += 2) {
            CG_LOAD(fa1, fb1, 2 * (pr + 1));
            __builtin_amdgcn_sched_barrier(0);
            CG_MMA(fa0, fb0);
            __builtin_amdgcn_sched_barrier(0);
            if (pr + 2 < npair) CG_LOAD(fa0, fb0, 2 * (pr + 2));
            __builtin_amdgcn_sched_barrier(0);
            CG_MMA(fa1, fb1);
            __builtin_amdgcn_sched_barrier(0);
        }
#undef CG_LOAD
#undef CG_MMA
#pragma unroll
        for (int m = 0; m < 4; ++m)
#pragma unroll
            for (int n = 0; n < 4; ++n) *(LAS f32x4*)(RED + (wq * 64 + 16 * m + i) * 68 + 16 * n + 4 * q) = acc[m][n];
        __syncthreads();
        { const int row = tid >> 3, c8 = (tid & 7) * 8; f32x4 lo = {0.f, 0.f, 0.f, 0.f}, hi = {0.f, 0.f, 0.f, 0.f};
#pragma unroll
          for (int w8 = 0; w8 < 8; ++w8) { lo = lo + *(const LAS f32x4*)(RED + (w8 * 64 + row) * 68 + c8); hi = hi + *(const LAS f32x4*)(RED + (w8 * 64 + row) * 68 + c8 + 4); }
          E(64 * rb + row, 64 * nb + c8, lo, hi); }
        __syncthreads();
    }
}

struct Args { const float* in[41]; float* out; unsigned char* ws; int ph_lo, ph_hi; };
static_assert(sizeof(Args) == 41 * 8 + 8 + 8 + 8, "Args has no padding");
struct KC {
    LAS unsigned char* lds; char* lds_gen; unsigned char* ws; float* out;
    int tid, lane, wave, G, bx, vcu, gw, NGW, gtid, NT, lo, hi, ph;
    XcdBarrier bar;
};
#ifndef PROBE_REP
#define PROBE_REP 1
#endif
#ifndef PROBE_ATT
#define PROBE_ATT 1
#endif
#if PROBE_REP == 2
#define REP2(x) do { x; __syncthreads(); x; } while (0)
#else
#define REP2(x) do { x; } while (0)
#endif
#define PH_ON (K.ph >= K.lo && K.ph < K.hi)
#define SEAM() do { if (K.ph >= K.lo && K.ph + 1 < K.hi) xcd_barrier(K.bar); ++K.ph; } while (0)
#define WSP(T, off) ((T*)(K.ws + (off)))

template <int LAYER> __device__ __forceinline__ void run_layer(KC& K, const Args& args) {
    constexpr int kind = LAYER % 3, jl = LAYER / 3;
    const float* modL = WSP(float, WS_MOD) + (size_t)LAYER * 2 * MODW;
    if (PH_ON) REP2(norm_mod_phase(WSP(bf16, WS_X), args.in[6] + (size_t)LAYER * DM, modL, 0, 4096, WSP(bf16, WS_H), K.gw, K.NGW, K.lane, LAYER == 0 ? args.in[2] : nullptr, LAYER == 0 ? args.in[0] : nullptr));
    SEAM();
    if constexpr (kind == 0) {
        if (PH_ON) { pg8::Gemm g{WSP(bf16, WS_H), WSP(bf16, WS_WSI) + (size_t)jl * SSD_INC * 4096, TT, SSD_INC, 4096}; pg8::StaticOrder S; S.init(TT, SSD_INC, K.G, K.bx);
            pg8::EpiStore E{WSP(bf16, WS_BIG), SSD_ZXW, nullptr, 72, WSP(float, WS_DT), args.in[16] + (size_t)jl * 256, 0};
            pg8::gemm_phase<pg8::EpiStore, pg8::StaticOrder, true, true>(K.lds, g, S, E);
            { const int first = ((TT / 256) * (SSD_INC / 256)) % K.G;
              if (first == 0 || K.bx >= first) {
                  __syncthreads();
                  LAS float* scr = (LAS float*)(K.lds + K.wave * 16384);
                  const int gwt = (K.bx - first) * NWAVES + K.wave, ngwt = (K.G - first) * NWAVES;
                  if constexpr (LAYER == 0) {
                      transpose_matrix(args.in[30], 4096, 4096, WSP(bf16, WS_WQKV), 0, scr, gwt, ngwt, K.lane);
                      transpose_matrix(args.in[31], 4096, 4096, WSP(bf16, WS_WQKV), 4096, scr, gwt, ngwt, K.lane);
                      transpose_matrix(args.in[32], 4096, 4096, WSP(bf16, WS_WQKV), 8192, scr, gwt, ngwt, K.lane);
                      transpose_matrix(args.in[33], 4096, 4096, WSP(bf16, WS_WO), 0, scr, gwt, ngwt, K.lane);
                  } else {
                      transpose_matrix(args.in[8] + (size_t)LAYER * 4096 * 8192, 4096, 8192, WSP(bf16, WS_WUP) + (size_t)LAYER * 8192 * 4096, 0, scr, gwt, ngwt, K.lane);
                      transpose_matrix(args.in[11] + (size_t)LAYER * 4096 * 4096, 4096, 4096, WSP(bf16, WS_WDN) + (size_t)LAYER * 4096 * 4096, 0, scr, gwt, ngwt, K.lane);
                  }
              } } }
        SEAM();
        if (PH_ON) REP2(ssd_conv_phase(WSP(bf16, WS_BIG), args.in[13] + (size_t)jl * 5 * SSD_CC, args.in[14] + (size_t)jl * SSD_CC, WSP(bf16, WS_XBC), K.gw, K.NGW, K.lane));
        SEAM();
        if (PH_ON) REP2(ssd_scan_phase(WSP(bf16, WS_XBC), WSP(float, WS_DT), args.in[15] + (size_t)jl * 256, args.in[17] + (size_t)jl * 128, WSP(bf16, WS_Y0), WSP(bf16, WS_Y1), K.lds, K.tid));
        SEAM();
        if (PH_ON) REP2(ssd_finish_phase(WSP(bf16, WS_Y0), WSP(bf16, WS_Y1), WSP(bf16, WS_BIG), args.in[18] + (size_t)jl * 8192, WSP(bf16, WS_A2), K.gw, K.NGW, K.lane));
        SEAM();
        if (PH_ON) { const bf16* Wt = WSP(bf16, WS_WSO) + (size_t)jl * 4096 * 8192;
            pg8::Gemm g{WSP(bf16, WS_A2) + (size_t)TC * 8192, Wt, TL, 4096, 8192}; pg8::StaticOrder S; S.init(TL, 4096, K.G, K.bx);
            pg8::EpiResid E{WSP(bf16, WS_X), modL + 8192, modL + MODW + 8192, nullptr, TC, LAYER == 0 ? args.in[0] - (size_t)TC * DM : nullptr};
            pg8::gemm_phase<pg8::EpiResid, pg8::StaticOrder, true, true>(K.lds, g, S, E);
            if (LAYER < DEPTH - 1) ctx_gemm(WSP(bf16, WS_A2), Wt, 4096, 8192, CtxResid{WSP(bf16, WS_X), modL + MODW + 8192, LAYER == 0 ? args.in[2] : nullptr}, K.lds, K.tid, K.vcu, K.G); }
        SEAM();
    } else if constexpr (kind == 1) {
        if (PH_ON) REP2(s5_mixer_phase(WSP(bf16, WS_H), args.in[20], args.in[21], args.in[22], args.in[23], args.in[24], args.in[25], args.in[26], args.in[27], WSP(bf16, WS_Y0), WSP(bf16, WS_A2), K.lds, K.tid));
        SEAM();
        if (PH_ON) { pg8::Gemm g{WSP(bf16, WS_A2) + (size_t)TC * 4096, WSP(bf16, WS_WGL), TL, 8192, 4096}; pg8::StaticOrder S; S.init(TL, 8192, K.G, K.bx);
            pg8::EpiStore E{WSP(bf16, WS_BIG), 8192, args.in[29], -1, nullptr, nullptr, TC};
            pg8::gemm_phase<pg8::EpiStore, pg8::StaticOrder, true, true>(K.lds, g, S, E);
            ctx_gemm(WSP(bf16, WS_A2), WSP(bf16, WS_WGL), 8192, 4096, CtxStore{WSP(bf16, WS_BIG), 8192, args.in[29]}, K.lds, K.tid, K.vcu, K.G); }
        SEAM();
        if (PH_ON) s5_glu_norm_phase(WSP(bf16, WS_BIG), modL, WSP(bf16, WS_X), args.in[7] + (size_t)LAYER * DM, WSP(bf16, WS_H), K.gw, K.NGW, K.lane);
        SEAM();
    } else {
        if (PH_ON) { pg8::Gemm g{WSP(bf16, WS_H) + (size_t)TC * 4096, WSP(bf16, WS_WQKV), TL, 12288, 4096}; pg8::StaticOrder S; S.init(TL, 12288, K.G, K.bx);
            pg8::EpiStore E{WSP(bf16, WS_BIG), 12288, nullptr, -1, nullptr, nullptr, TC};
            pg8::gemm_phase<pg8::EpiStore, pg8::StaticOrder, true, true>(K.lds, g, S, E);
            ctx_gemm(WSP(bf16, WS_H), WSP(bf16, WS_WQKV), 12288, 4096, CtxStore{WSP(bf16, WS_BIG), 12288, nullptr}, K.lds, K.tid, K.vcu, K.G); }
        SEAM();
        if (PH_ON) da_qknorm_phase(WSP(bf16, WS_BIG), args.in[34], args.in[35], WSP(float, WS_ROPE), WSP(unsigned, WS_CTL) + CW_KMAX, K.gw, K.NGW, K.lane);
        SEAM();
        if (PH_ON) {
            const float* lq1 = args.in[36]; const float* lk1 = args.in[37]; const float* lq2 = args.in[38]; const float* lk2 = args.in[39];
            const float lambda_init = 0.8f - 0.6f * expf(-0.3f * (float)LAYER);
            const float s1 = wave_sum(lq1[K.lane] * lk1[K.lane] + lq1[K.lane + 64] * lk1[K.lane + 64]), s2 = wave_sum(lq2[K.lane] * lk2[K.lane] + lq2[K.lane + 64] * lk2[K.lane + 64]);
            const float lam = expf(s1) - expf(s2) + lambda_init;
            const int nlp = (1024 + K.G - 1) / K.G, ncp = (32 + K.G - 1) / K.G;
            if (K.tid == 0) { char* pr = K.lds_gen + att2::L_PRM; *(float*)pr = lam; *(float*)(pr + 4) = 1.f - lambda_init; *(const float**)(pr + 8) = args.in[40];
                              *(float**)(pr + 16) = WSP(float, WS_Y0); *(bf16**)(pr + 24) = WSP(bf16, WS_A2); }
            __syncthreads();
            for (int i = 0; i < 2 * (nlp + ncp); ++i) {
                const int ip = i >> 1;
                int h16, qrow, seq;
                if (ip < nlp) { const int v = ip * K.G + K.vcu; if (v >= 1024) continue; h16 = v >> 6; qrow = TC + 128 * (v & 63); seq = TT; }
                else { const int v = (ip - nlp) * K.G + K.vcu; if (v >= 32) continue; h16 = v >> 1; qrow = 128 * (v & 1); seq = TC; }
                const int h32 = 2 * h16 + (i & 1);
                const bf16* QKV = WSP(bf16, WS_BIG);
                const float kmax2 = __uint_as_float(__hip_atomic_load(WSP(unsigned, WS_CTL) + CW_KMAX + h32, __ATOMIC_RELAXED, __HIP_MEMORY_SCOPE_AGENT));
                att2::attn_unit(QKV + (size_t)qrow * 12288 + h32 * 128, QKV + 4096 + h32 * 128, QKV + 8192 + h16 * 256,
                                WSP(float, WS_Y0) + (size_t)qrow * 8192 + h16 * 256, seq, kmax2, K.lds_gen, i & 1);
            }
        }
        SEAM();
        if (PH_ON) { pg8::Gemm g{WSP(bf16, WS_A2) + (size_t)TC * 4096, WSP(bf16, WS_WO), TL, 4096, 4096}; pg8::StaticOrder S; S.init(TL, 4096, K.G, K.bx);
            pg8::EpiResid E{WSP(bf16, WS_X), modL + 8192, modL + MODW + 8192, nullptr, TC};
            pg8::gemm_phase<pg8::EpiResid, pg8::StaticOrder, true, true>(K.lds, g, S, E);
            ctx_gemm(WSP(bf16, WS_A2), WSP(bf16, WS_WO), 4096, 4096, CtxResid{WSP(bf16, WS_X), modL + MODW + 8192, nullptr}, K.lds, K.tid, K.vcu, K.G); }
        SEAM();
    }
    if constexpr (kind != 1) {
    if (PH_ON) REP2(norm_mod_phase(WSP(bf16, WS_X), args.in[7] + (size_t)LAYER * DM, modL, 12288, 16384, WSP(bf16, WS_H), K.gw, K.NGW, K.lane));
    SEAM();
    }
    if (PH_ON) { const bf16* Wt = WSP(bf16, WS_WUP) + (size_t)LAYER * 8192 * 4096;
        pg8::Gemm g{WSP(bf16, WS_H) + (size_t)TC * 4096, Wt, TL, 8192, 4096}; pg8::StaticOrder S; S.init(TL, 8192, K.G, K.bx);
        pg8::EpiStore E{WSP(bf16, WS_BIG), 8192, nullptr, -1, nullptr, nullptr, TC};
        pg8::gemm_phase<pg8::EpiStore, pg8::StaticOrder, true, true>(K.lds, g, S, E);
        if (LAYER < DEPTH - 1) ctx_gemm(WSP(bf16, WS_H), Wt, 8192, 4096, CtxStore{WSP(bf16, WS_BIG), 8192, nullptr}, K.lds, K.tid, K.vcu, K.G); }
    SEAM();
    if (PH_ON) REP2(ffn_conv_phase(WSP(bf16, WS_BIG), args.in[9] + (size_t)LAYER * 3 * 8192, args.in[10] + (size_t)LAYER * 8192, WSP(bf16, WS_A2), K.gw, K.NGW, K.lane));
    SEAM();
    if (PH_ON) { const bf16* Wt = WSP(bf16, WS_WDN) + (size_t)LAYER * 4096 * 4096;
        pg8::Gemm g{WSP(bf16, WS_A2) + (size_t)TC * 4096, Wt, TL, 4096, 4096}; pg8::StaticOrder S; S.init(TL, 4096, K.G, K.bx);
        pg8::EpiResid E{WSP(bf16, WS_X), modL + 20480, modL + MODW + 20480, LAYER == DEPTH - 1 ? K.out : nullptr, TC};
        pg8::gemm_phase<pg8::EpiResid, pg8::StaticOrder, true, true>(K.lds, g, S, E);
        if (LAYER < DEPTH - 1) ctx_gemm(WSP(bf16, WS_A2), Wt, 4096, 4096, CtxResid{WSP(bf16, WS_X), modL + MODW + 20480, nullptr}, K.lds, K.tid, K.vcu, K.G); }
    SEAM();
}

__global__ void __launch_bounds__(NWAVES * 64, 2) hybrid_fwd(Args args) {
    extern __shared__ __attribute__((aligned(16))) unsigned char lds_raw[];
    KC K;
    K.lds = (LAS unsigned char*)lds_raw; K.lds_gen = (char*)lds_raw; K.ws = args.ws; K.out = args.out;
    K.tid = threadIdx.x; K.lane = K.tid & 63; K.wave = __builtin_amdgcn_readfirstlane(K.tid >> 6);
    K.G = gridDim.x; K.bx = blockIdx.x;
    K.vcu = (K.G % 8 == 0) ? (K.bx % 8) * (K.G / 8) + K.bx / 8 : K.bx;
    K.gw = K.vcu * NWAVES + K.wave; K.NGW = K.G * NWAVES; K.gtid = K.bx * NWAVES * 64 + K.tid; K.NT = K.G * NWAVES * 64;
    unsigned* ctl = (unsigned*)(K.ws + WS_CTL);
    for (int u = K.tid; u < (LDS_BYTES - LDSCTL_OFF) / 4; u += NWAVES * 64) ((LAS unsigned*)(K.lds + LDSCTL_OFF))[u] = 0u;
    __syncthreads();
    volatile LAS unsigned* MISC = (volatile LAS unsigned*)(K.lds + MISC_OFF);
    K.bar = xcd_barrier_post(ctl + CW_BAR, MISC + 8);
    K.lo = args.ph_lo; K.hi = args.ph_hi; K.ph = 0;

    if (PH_ON) {
        LAS float* scr = (LAS float*)(K.lds + K.wave * 16384);
        const int gw = K.gw, NGW = K.NGW, lane = K.lane;
        for (int l = 0; l < DEPTH - 1; ++l) transpose_matrix(args.in[8] + (size_t)l * 4096 * 8192, 4096, 8192, WSP(bf16, WS_WUP) + (size_t)l * 8192 * 4096, 0, scr, gw, NGW, lane);
        for (int l = 0; l < DEPTH - 1; ++l) transpose_matrix(args.in[11] + (size_t)l * 4096 * 4096, 4096, 4096, WSP(bf16, WS_WDN) + (size_t)l * 4096 * 4096, 0, scr, gw, NGW, lane);
        for (int l = 0; l < 2; ++l) transpose_matrix(args.in[12] + (size_t)l * 4096 * SSD_INC, 4096, SSD_INC, WSP(bf16, WS_WSI) + (size_t)l * SSD_INC * 4096, 0, scr, gw, NGW, lane);
        for (int l = 0; l < 2; ++l) transpose_matrix(args.in[19] + (size_t)l * 8192 * 4096, 8192, 4096, WSP(bf16, WS_WSO) + (size_t)l * 4096 * 8192, 0, scr, gw, NGW, lane);
        transpose_matrix(args.in[28], 4096, 8192, WSP(bf16, WS_WGL), 0, scr, gw, NGW, lane);
        { float* ROPE = WSP(float, WS_ROPE);
          for (int i = K.gtid; i < 128 * 32; i += K.NT) { const int pos = i >> 5, f = i & 31; const float inv = powf(10000.f, -(float)f / 32.f); const float ang = (float)pos * inv;
            ROPE[2 * i] = cosf(ang); ROPE[2 * i + 1] = sinf(ang); } }
        __syncthreads();
        mod_phase(args.in[1], args.in[3], args.in[4], args.in[5], WSP(float, WS_MOD), K.lds, K.tid, K.wave, K.lane);
    }
    SEAM();
    run_layer<0>(K, args);
    run_layer<1>(K, args);
    run_layer<2>(K, args);
    run_layer<3>(K, args);
}
#undef PH_ON
#undef SEAM
#undef WSP

extern "C" void kernel_launch(void* const* d_in, const int* in_sizes, int n_in, void* d_out, int out_size, void* d_ws, size_t ws_size, hipStream_t stream) {
    static int grid = 0;
    if (grid == 0) {
        if (n_in != 41 || out_size != TL * DM || ws_size < WS_END) { fprintf(stderr, "kernel_launch: unexpected shapes: n_in %d out %d ws %zu (need %zu)\n", n_in, out_size, ws_size, (size_t)WS_END); grid = -1; return; }
        int dev = 0, cus = 0, per_cu = 0;
        if (hipGetDevice(&dev) != hipSuccess || hipDeviceGetAttribute(&cus, hipDeviceAttributeMultiprocessorCount, dev) != hipSuccess) { grid = -1; return; }
        if (hipFuncSetAttribute((const void*)hybrid_fwd, hipFuncAttributeMaxDynamicSharedMemorySize, LDS_BYTES) != hipSuccess) { fprintf(stderr, "kernel_launch: hipFuncSetAttribute failed\n"); grid = -1; return; }
        if (hipOccupancyMaxActiveBlocksPerMultiprocessor(&per_cu, (const void*)hybrid_fwd, NWAVES * 64, LDS_BYTES) != hipSuccess || per_cu < 1) { fprintf(stderr, "kernel_launch: occupancy query says %d\n", per_cu); }
        (void)hipGetLastError();
        grid = cus;
    }
    if (grid < 0) return;
    if (hipMemsetAsync((char*)d_ws + WS_CTL, 0, CTL_BYTES, stream) != hipSuccess) return;
    Args a{};
    for (int i = 0; i < 41; ++i) a.in[i] = (const float*)d_in[i];
    a.out = (float*)d_out; a.ws = (unsigned char*)d_ws; a.ph_lo = 0; a.ph_hi = 1000;
    hipLaunchKernelGGL(hybrid_fwd, dim3(grid), dim3(NWAVES * 64), LDS_BYTES, stream, a);
    const hipError_t le = hipPeekAtLastError();
    if (le != hipSuccess) fprintf(stderr, "kernel_launch: launch failed: %s\n", hipGetErrorName(le));
}
```

```cpp
#include <hip/hip_runtime.h>
#include <cstdio>
#include <cstdint>
namespace pg8 {
#define PG8_LAS __attribute__((address_space(3)))
typedef unsigned short bf16_t;
typedef short bf16x8 __attribute__((ext_vector_type(8)));
typedef float f32x4 __attribute__((ext_vector_type(4)));
typedef unsigned u32x4 __attribute__((ext_vector_type(4)));
constexpr int BM = 256, BK = 64, HALF = 128, HTB = HALF * BK * 2  , STAGE_BYTES = 8 * HTB, NXCD = 8, WGM = 8;

__host__ __device__ __forceinline__ int lds_byte(int r, int c) { const int st = (r >> 4) * 2 + (c >> 5), rr = r & 15, cc = c & 31, ob = rr * 64 + cc * 2; return st * 1024 + (ob ^ (((ob >> 9) & 1) << 5)); }
__host__ __device__ __forceinline__ void stage_rc(int b, int& R, int& C) { const int st = b / 1024, sb = b % 1024, swz = sb ^ (((sb >> 9) & 1) << 5); R = (st >> 1) * 16 + swz / 64; C = (st & 1) * 32 + (swz % 64) / 2; }
__host__ __device__ __forceinline__ int perm32(int rho) { const int n = rho >> 4, i = rho & 15; return 8 * (i >> 2) + 4 * n + (i & 3); }

struct Unit { int pm, pn; };
struct Gemm { const bf16_t* A; const bf16_t* Bt; int M, N, K; };

struct StaticOrder {
    int nM, nN, nwg, G, c;
    __host__ __device__ void init(int M, int N, int G_, int c_) { nM = M / BM; nN = N / BM; nwg = nM * nN; G = G_; c = c_; }
    __host__ __device__ bool next(int i, Unit& u) const {
        const long L = (long)i * G + c; if (L >= nwg) return false;
        int wgid = (int)L; { const int q = nwg / NXCD, r = nwg % NXCD, xcd = wgid % NXCD, off = wgid / NXCD; wgid = (xcd < r ? xcd * (q + 1) : r * (q + 1) + (xcd - r) * q) + off; }
        const int nig = WGM * nN, gid = wgid / nig, fm = gid * WGM, gsz = (nM - fm) < WGM ? (nM - fm) : WGM;
        u.pm = fm + ((wgid % nig) % gsz); u.pn = (wgid % nig) / gsz; return true;
    }
    __device__ __forceinline__ void a_ready(const Unit&) const {}
    __device__ __forceinline__ void done(const Unit&) const {}
};

__device__ __forceinline__ unsigned cvt_pk_bf16(float lo, float hi) { unsigned r; asm volatile("v_cvt_pk_bf16_f32 %0, %1, %2" : "=v"(r) : "v"(lo), "v"(hi)); return r; }
typedef float f32x2 __attribute__((ext_vector_type(2)));
__device__ __forceinline__ float softplus_f(float x) { return fmaxf(x, 0.f) + __logf(1.f + __expf(-fabsf(x))); }
struct EpiStore {
    static constexpr bool PERM = true, AFTER_DRAIN = false;
    bf16_t* O; int ldc; const float* bias; int dt_pn; float* DT; const float* dtb; int row_off;
    __device__ __forceinline__ void operator()(const f32x4 (&acc)[2][2][4][2], const Unit& u, int wr, int wc, int fr, int fq) const {
        const int row0 = row_off + u.pm * BM + wr * 64 + fr; const int colt = u.pn * BM;
        if (u.pn == dt_pn) {
            const int lc0 = wc * 32 + 8 * fq;
#pragma unroll
            for (int ai = 0; ai < 2; ++ai)
#pragma unroll
                for (int m = 0; m < 4; ++m) { float* rowp = DT + (size_t)(row0 + ai * HALF + m * 16) * 256 + lc0;
#pragma unroll
                    for (int bj = 0; bj < 2; ++bj)
#pragma unroll
                        for (int n = 0; n < 2; ++n) { const f32x4 b = *(const f32x4*)(dtb + lc0 + bj * HALF + 4 * n); const f32x4 v = acc[ai][bj][m][n] + b;
                            f32x4 o; o[0] = softplus_f(v[0]); o[1] = softplus_f(v[1]); o[2] = softplus_f(v[2]); o[3] = softplus_f(v[3]);
                            *(f32x4*)(rowp + bj * HALF + 4 * n) = o; } }
            return;
        }
        const int col0 = colt + wc * 32 + 8 * fq;
        f32x4 bv[2][2];
#pragma unroll
        for (int bj = 0; bj < 2; ++bj)
#pragma unroll
            for (int n = 0; n < 2; ++n) bv[bj][n] = bias ? *(const f32x4*)(bias + col0 + bj * HALF + 4 * n) : (f32x4){0.f, 0.f, 0.f, 0.f};
#pragma unroll
        for (int ai = 0; ai < 2; ++ai)
#pragma unroll
            for (int m = 0; m < 4; ++m) { bf16_t* rowp = O + (size_t)(row0 + ai * HALF + m * 16) * ldc + col0;
#pragma unroll
                for (int bj = 0; bj < 2; ++bj) { const f32x4 v0 = acc[ai][bj][m][0] + bv[bj][0], v1 = acc[ai][bj][m][1] + bv[bj][1];
                    u32x4 w; w.x = cvt_pk_bf16(v0[0], v0[1]); w.y = cvt_pk_bf16(v0[2], v0[3]); w.z = cvt_pk_bf16(v1[0], v1[1]); w.w = cvt_pk_bf16(v1[2], v1[3]);
                    *(u32x4*)(rowp + bj * HALF) = w; } }
    }
};
typedef unsigned u32x2r __attribute__((ext_vector_type(2)));
struct EpiResid {
    static constexpr bool PERM = true, AFTER_DRAIN = false;
    bf16_t* X; const float* gate_lat; const float* gate_ctx; float* out; int row_off; const float* Xrd;
    __device__ __forceinline__ void operator()(const f32x4 (&acc)[2][2][4][2], const Unit& u, int wr, int wc, int fr, int fq) const {
        const int row0 = row_off + u.pm * BM + wr * 64 + fr, col0 = u.pn * BM + wc * 32 + 8 * fq;
        const float* gate = (row_off + u.pm * BM < 256) ? gate_ctx : gate_lat;
        f32x4 gv[2][2];
#pragma unroll
        for (int bj = 0; bj < 2; ++bj)
#pragma unroll
            for (int n = 0; n < 2; ++n) gv[bj][n] = *(const f32x4*)(gate + col0 + bj * HALF + 4 * n);
#pragma unroll
        for (int ai = 0; ai < 2; ++ai) {
            f32x4 xv[4][2][2];
            if (Xrd != nullptr) {
#pragma unroll
                for (int m = 0; m < 4; ++m) { const float* rowp = Xrd + (size_t)(row0 + ai * HALF + m * 16) * 4096 + col0;
#pragma unroll
                    for (int bj = 0; bj < 2; ++bj)
#pragma unroll
                        for (int n = 0; n < 2; ++n) xv[m][bj][n] = *(const f32x4*)(rowp + bj * HALF + 4 * n); }
            } else {
                u32x4 xb[4][2];
#pragma unroll
                for (int m = 0; m < 4; ++m) { const bf16_t* rowp = X + (size_t)(row0 + ai * HALF + m * 16) * 4096 + col0;
#pragma unroll
                    for (int bj = 0; bj < 2; ++bj) xb[m][bj] = *(const u32x4*)(rowp + bj * HALF); }
                asm volatile("" ::: "memory");
#pragma unroll
                for (int m = 0; m < 4; ++m)
#pragma unroll
                    for (int bj = 0; bj < 2; ++bj) { const unsigned w0 = xb[m][bj].x, w1 = xb[m][bj].y, w2 = xb[m][bj].z, w3 = xb[m][bj].w;
                        xv[m][bj][0] = f32x4{__builtin_bit_cast(float, w0 << 16), __builtin_bit_cast(float, w0 & 0xffff0000u), __builtin_bit_cast(float, w1 << 16), __builtin_bit_cast(float, w1 & 0xffff0000u)};
                        xv[m][bj][1] = f32x4{__builtin_bit_cast(float, w2 << 16), __builtin_bit_cast(float, w2 & 0xffff0000u), __builtin_bit_cast(float, w3 << 16), __builtin_bit_cast(float, w3 & 0xffff0000u)}; }
            }
            asm volatile("" ::: "memory");
#pragma unroll
            for (int m = 0; m < 4; ++m) { const int r = row0 + ai * HALF + m * 16;
#pragma unroll
                for (int bj = 0; bj < 2; ++bj) { const f32x4 o0 = xv[m][bj][0] + gv[bj][0] * acc[ai][bj][m][0], o1 = xv[m][bj][1] + gv[bj][1] * acc[ai][bj][m][1];
                    if (out != nullptr) { if (r >= 256) { float* op = out + (size_t)(r - 256) * 4096 + col0 + bj * HALF; *(f32x4*)op = o0; *(f32x4*)(op + 4) = o1; } }
                    else { u32x4 w; w.x = cvt_pk_bf16(o0.x, o0.y); w.y = cvt_pk_bf16(o0.z, o0.w); w.z = cvt_pk_bf16(o1.x, o1.y); w.w = cvt_pk_bf16(o1.z, o1.w); *(u32x4*)(X + (size_t)r * 4096 + col0 + bj * HALF) = w; } } }
            asm volatile("" ::: "memory");
        }
    }
};
template <class Epi, class Sched, bool ALIGN_EPI = false, bool SP2 = false>
__device__ __forceinline__ void gemm_phase(PG8_LAS unsigned char* lds, const Gemm g, const Sched& S, const Epi& E) {
    const int tid = threadIdx.x, wid = __builtin_amdgcn_readfirstlane(tid >> 6), lane = tid & 63, wr = wid >> 2, wc = wid & 3, fr = lane & 15, fq = lane >> 4;
    const int K = g.K, nt = K / BK;
    unsigned voffA[2], voffB[2];
#pragma unroll
    for (int i = 0; i < 2; ++i) { int R, C; stage_rc(tid * 16 + i * 8192, R, C); const int Rb = Epi::PERM ? ((R & ~31) + perm32(R & 31)) : R;
        voffA[i] = (unsigned)(R * K + C) * 2u; voffB[i] = (unsigned)(Rb * K + C) * 2u; }
    const size_t kstep = (size_t)(BK * 2);
    const size_t hstep = (size_t)HALF * K * 2;
    const size_t tstep = 2 * hstep;
    const unsigned ldsw = (unsigned)wid * 1024u;
    const int aoff = lds_byte(wr * 64 + fr, fq * 8), boff = lds_byte(wc * 32 + fr, fq * 8);
#define PG8_SA(b, h) (((b) * 2 + (h)) * HTB)
#define PG8_SB(b, h) ((4 + (b) * 2 + (h)) * HTB)
#define PG8_STAGE(bufoff, gbase, voff) do { _Pragma("unroll") for (int _i = 0; _i < 2; ++_i) \
        __builtin_amdgcn_global_load_lds((const unsigned*)((const char*)(gbase) + (voff)[_i]), (PG8_LAS unsigned*)(lds + (bufoff) + ldsw + _i * 8192), 16, 0, 0); } while (0)
#define PG8_LDA(dst, b, h) do { _Pragma("unroll") for (int m = 0; m < 4; ++m) _Pragma("unroll") for (int k = 0; k < 2; ++k) dst[m][k] = *(const PG8_LAS bf16x8*)(lds + PG8_SA(b, h) + aoff + m * 2048 + k * 1024); } while (0)
#define PG8_LDB(dst, b, h) do { _Pragma("unroll") for (int n = 0; n < 2; ++n) _Pragma("unroll") for (int k = 0; k < 2; ++k) dst[n][k] = *(const PG8_LAS bf16x8*)(lds + PG8_SB(b, h) + boff + n * 2048 + k * 1024); } while (0)
#define PG8_MMA(ai, bj, At, Bt) do { __builtin_amdgcn_s_setprio(1); _Pragma("unroll") for (int m = 0; m < 4; ++m) _Pragma("unroll") for (int n = 0; n < 2; ++n) _Pragma("unroll") for (int k = 0; k < 2; ++k) \
        acc[ai][bj][m][n] = __builtin_amdgcn_mfma_f32_16x16x32_bf16(Bt[n][k], At[m][k], acc[ai][bj][m][n], 0, 0, 0); __builtin_amdgcn_s_setprio(0); } while (0)
#define PG8_WAIT_V(n) asm volatile("s_waitcnt vmcnt(" #n ")" ::: "memory")
#define PG8_WAIT_L(n) asm volatile("s_waitcnt lgkmcnt(" #n ")" ::: "memory")
#define PG8_BAR __builtin_amdgcn_s_barrier()
#define PG8_SCHED __builtin_amdgcn_sched_barrier(0)
    Unit cur, nxt; int ui = 0;
    if (!S.next(0, cur)) return;
    f32x4 acc[2][2][4][2];
#pragma unroll
    for (int a = 0; a < 2; ++a)
#pragma unroll
        for (int b = 0; b < 2; ++b)
#pragma unroll
            for (int m = 0; m < 4; ++m)
#pragma unroll
                for (int n = 0; n < 2; ++n) acc[a][b][m][n] = (f32x4){0.f, 0.f, 0.f, 0.f};
    bf16x8 At[4][2], B0[2][2], B1[2][2];
    const char* cA = (const char*)g.A + (size_t)cur.pm * tstep; const char* cB = (const char*)g.Bt + (size_t)cur.pn * tstep;
    S.a_ready(cur);
    if constexpr (SP2) {
        PG8_STAGE(PG8_SB(0, 0), cB, voffB); PG8_STAGE(PG8_SB(0, 1), cB + hstep, voffB); PG8_STAGE(PG8_SA(0, 0), cA, voffA); PG8_STAGE(PG8_SA(0, 1), cA + hstep, voffA);
        if (wr == 1) PG8_BAR;
        PG8_WAIT_V(2); PG8_BAR;
        PG8_STAGE(PG8_SB(1, 0), cB + kstep, voffB); PG8_STAGE(PG8_SA(1, 0), cA + kstep, voffA); PG8_STAGE(PG8_SB(1, 1), cB + hstep + kstep, voffB);
        PG8_WAIT_V(6); PG8_BAR;
    } else {
        PG8_STAGE(PG8_SB(0, 0), cB, voffB); PG8_STAGE(PG8_SA(0, 0), cA, voffA); PG8_STAGE(PG8_SB(0, 1), cB + hstep, voffB); PG8_STAGE(PG8_SA(0, 1), cA + hstep, voffA);
        if (wr == 1) PG8_BAR;
        PG8_WAIT_V(4); PG8_BAR;
        PG8_STAGE(PG8_SB(1, 0), cB + kstep, voffB); PG8_STAGE(PG8_SA(1, 0), cA + kstep, voffA); PG8_STAGE(PG8_SB(1, 1), cB + hstep + kstep, voffB);
        PG8_WAIT_V(6); PG8_BAR;
    }
    for (;;) {
        const bool has_next = S.next(ui + 1, nxt);
        const char* nA = has_next ? (const char*)g.A + (size_t)nxt.pm * tstep : cA; const char* nB = has_next ? (const char*)g.Bt + (size_t)nxt.pn * tstep : cB;
        for (int t = 0; t < nt; t += 2) {
            const bool last = (t == nt - 2);
            const char* a1 = cA + (size_t)(t + 1) * kstep;
            const char* a2 = last ? nA : cA + (size_t)(t + 2) * kstep; const char* b2 = last ? nB : cB + (size_t)(t + 2) * kstep;
            const char* a3 = a2 + kstep; const char* b3 = b2 + kstep;
            if (last && has_next) S.a_ready(nxt);
            if constexpr (SP2) {
            PG8_LDB(B0, 0, 0); PG8_LDB(B1, 0, 1); PG8_SCHED; PG8_LDA(At, 0, 0); PG8_STAGE(PG8_SA(1, 1), a1 + hstep, voffA);
            PG8_WAIT_V(8); PG8_WAIT_L(0); PG8_BAR; PG8_MMA(0, 0, At, B0); PG8_MMA(0, 1, At, B1); PG8_BAR; PG8_SCHED;
            PG8_LDA(At, 0, 1); PG8_STAGE(PG8_SB(0, 0), b2, voffB); PG8_STAGE(PG8_SB(0, 1), b2 + hstep, voffB); PG8_STAGE(PG8_SA(0, 0), a2, voffA);
            PG8_WAIT_V(8); PG8_WAIT_L(0); PG8_BAR; PG8_MMA(1, 0, At, B0); PG8_MMA(1, 1, At, B1); PG8_BAR; PG8_SCHED;
            PG8_LDB(B0, 1, 0); PG8_LDB(B1, 1, 1); PG8_SCHED; PG8_LDA(At, 1, 0); PG8_STAGE(PG8_SA(0, 1), a2 + hstep, voffA);
            PG8_WAIT_V(8); PG8_WAIT_L(0); PG8_BAR; PG8_MMA(0, 0, At, B0); PG8_MMA(0, 1, At, B1); PG8_BAR; PG8_SCHED;
            PG8_LDA(At, 1, 1); PG8_STAGE(PG8_SB(1, 0), b3, voffB); PG8_STAGE(PG8_SB(1, 1), b3 + hstep, voffB); PG8_STAGE(PG8_SA(1, 0), a3, voffA);
            PG8_WAIT_V(8); PG8_WAIT_L(0); PG8_BAR; PG8_MMA(1, 0, At, B0); PG8_MMA(1, 1, At, B1); PG8_BAR; PG8_SCHED;
            } else {
            PG8_LDB(B0, 0, 0); PG8_SCHED; PG8_LDA(At, 0, 0); PG8_STAGE(PG8_SA(1, 1), a1 + hstep, voffA);
            PG8_WAIT_L(8); PG8_BAR; PG8_WAIT_L(0); PG8_MMA(0, 0, At, B0); PG8_BAR; PG8_SCHED;
            PG8_LDB(B1, 0, 1); PG8_STAGE(PG8_SB(0, 0), b2, voffB);
            PG8_BAR; PG8_WAIT_L(0); PG8_MMA(0, 1, At, B1); PG8_BAR;
            PG8_LDA(At, 0, 1); PG8_STAGE(PG8_SA(0, 0), a2, voffA);
            PG8_BAR; PG8_WAIT_L(0); PG8_MMA(1, 0, At, B0); PG8_BAR; PG8_SCHED;
            PG8_STAGE(PG8_SB(0, 1), b2 + hstep, voffB);
            PG8_WAIT_V(6); PG8_BAR; PG8_MMA(1, 1, At, B1); PG8_BAR;
            PG8_LDB(B0, 1, 0); PG8_SCHED; PG8_LDA(At, 1, 0); PG8_STAGE(PG8_SA(0, 1), a2 + hstep, voffA);
            PG8_WAIT_L(8); PG8_BAR; PG8_WAIT_L(0); PG8_MMA(0, 0, At, B0); PG8_BAR; PG8_SCHED;
            PG8_LDB(B1, 1, 1); PG8_STAGE(PG8_SB(1, 0), b3, voffB);
            PG8_BAR; PG8_WAIT_L(0); PG8_MMA(0, 1, At, B1); PG8_BAR;
            PG8_LDA(At, 1, 1); PG8_STAGE(PG8_SA(1, 0), a3, voffA);
            PG8_BAR; PG8_WAIT_L(0); PG8_MMA(1, 0, At, B0); PG8_BAR; PG8_SCHED;
            PG8_STAGE(PG8_SB(1, 1), b3 + hstep, voffB);
            PG8_WAIT_V(6); PG8_BAR; PG8_MMA(1, 1, At, B1); PG8_BAR;
            }
        }
        if constexpr (ALIGN_EPI) { if (wr == 0) PG8_BAR; }
        if constexpr (!Epi::AFTER_DRAIN) { E(acc, cur, wr, wc, fr, fq); S.done(cur); }
        if (!has_next) break;
#pragma unroll
        for (int a = 0; a < 2; ++a)
#pragma unroll
            for (int b = 0; b < 2; ++b)
#pragma unroll
                for (int m = 0; m < 4; ++m)
#pragma unroll
                    for (int n = 0; n < 2; ++n) acc[a][b][m][n] = (f32x4){0.f, 0.f, 0.f, 0.f};
        cur = nxt; cA = nA; cB = nB; ++ui;
        if constexpr (ALIGN_EPI) { if (wr == 1) PG8_BAR; }
    }
    PG8_WAIT_V(0);
    if constexpr (!ALIGN_EPI) { if (wr == 0) PG8_BAR; }
    PG8_BAR;
    if constexpr (Epi::AFTER_DRAIN) { E.fused(acc, cur, wr, wc, fr, fq, lds, wid, lane); S.done(cur); }
#undef PG8_SA
#undef PG8_SB
#undef PG8_STAGE
#undef PG8_LDA
#undef PG8_LDB
#undef PG8_MMA
#undef PG8_WAIT_V
#undef PG8_WAIT_L
#undef PG8_BAR
#undef PG8_SCHED
}
}
namespace att {
using bf16 = unsigned short;
constexpr int   D = 128, NW = 8, QBLK = 32, KVBLK = 64;
constexpr float SCALE = 0.088388347648318440f;
constexpr float THR = 8.f;
constexpr int SDEPTH = 2;
constexpr int LDQ = 12288, LDK = 12288, LDO = 8192;
constexpr size_t SHM_V = KVBLK * D * 2, SHM_K = KVBLK * D * 2, SHM_ATTN = 2 * SHM_V + 2 * SHM_K + NW * 64 * 4;
using bf16x8 = __attribute__((ext_vector_type(8))) short;
using s16x4  = __attribute__((ext_vector_type(4))) short;
using f32x16 = __attribute__((ext_vector_type(16))) float;
using f32x8  = __attribute__((ext_vector_type(8))) float;
using u32x4  = __attribute__((ext_vector_type(4))) unsigned;
#define KSWZ(row, colB) ((row) * 256 + ((colB) ^ (((row) & 7) << 4)))
#define SBAR() __builtin_amdgcn_sched_barrier(0)
__device__ __forceinline__ int crow(int r, int hi) { return (r & 3) + 8 * (r >> 2) + 4 * hi; }
__device__ __forceinline__ unsigned cvtpk(float lo, float hi) {
  unsigned r; asm volatile("v_cvt_pk_bf16_f32 %0, %1, %2" : "=v"(r) : "v"(lo), "v"(hi)); return r;
}
template <typename TIn> struct Stage;
template <> struct Stage<bf16>  { using T = bf16x8;
  __device__ static __forceinline__ T ld8(const bf16* p) { return *reinterpret_cast<const bf16x8*>(p); }
  __device__ static __forceinline__ bf16x8 tobf(T x) { return x; } };
template <> struct Stage<float> { using T = f32x8;
  __device__ static __forceinline__ T ld8(const float* p) { return *reinterpret_cast<const f32x8*>(p); }
  __device__ static __forceinline__ bf16x8 tobf(T x) {
    u32x4 w = {cvtpk(x[0], x[1]), cvtpk(x[2], x[3]), cvtpk(x[4], x[5]), cvtpk(x[6], x[7])}; return *reinterpret_cast<bf16x8*>(&w); } };

__device__ __forceinline__ void partialSM(f32x16& p0, f32x16& p1, float& m_reg, float& mn, float& alpha) {
  constexpr float C = SCALE * 1.4426950408889634f;
  float pmax = p0[0]; for (int r = 1; r < 16; ++r) pmax = fmaxf(pmax, p0[r]); for (int r = 0; r < 16; ++r) pmax = fmaxf(pmax, p1[r]);
  { auto rr = __builtin_amdgcn_permlane32_swap(__float_as_uint(pmax), __float_as_uint(pmax), false, false);
    pmax = fmaxf(__uint_as_float(rr[0]), __uint_as_float(rr[1])); }
  if (__builtin_expect(__all(pmax - m_reg <= THR / SCALE), 1)) { mn = m_reg; alpha = 1.f; }
  else { mn = fmaxf(m_reg, pmax); alpha = __builtin_amdgcn_exp2f((m_reg - mn) * C); m_reg = mn; }
  float mnC = -mn * C;
  for (int r = 0; r < 16; ++r) p0[r] = fmaf(p0[r], C, mnC); for (int r = 0; r < 16; ++r) p1[r] = fmaf(p1[r], C, mnC);
  for (int r = 0; r < 16; ++r) p0[r] = __builtin_amdgcn_exp2f(p0[r]);
}
__device__ __forceinline__ void finishSM(f32x16& p0, f32x16& p1, float alpha, float& l_reg, bf16x8& pa0, bf16x8& pa1, bf16x8& pa2, bf16x8& pa3) {
  for (int r = 0; r < 16; ++r) p1[r] = __builtin_amdgcn_exp2f(p1[r]);
  float ps = 0; for (int r = 0; r < 16; ++r) ps += p0[r]; for (int r = 0; r < 16; ++r) ps += p1[r];
  { auto rr = __builtin_amdgcn_permlane32_swap(__float_as_uint(ps), __float_as_uint(ps), false, false);
    ps = __uint_as_float(rr[0]) + __uint_as_float(rr[1]); }
  l_reg = l_reg * alpha + ps;
#define PK4(P, BASE, OUT) do { unsigned a0 = cvtpk(P[BASE + 0], P[BASE + 1]), a1 = cvtpk(P[BASE + 2], P[BASE + 3]);   \
    unsigned b0 = cvtpk(P[BASE + 4], P[BASE + 5]), b1 = cvtpk(P[BASE + 6], P[BASE + 7]);                              \
    auto r0 = __builtin_amdgcn_permlane32_swap(a0, b0, false, false); auto r1 = __builtin_amdgcn_permlane32_swap(a1, b1, false, false); \
    u32x4 w = {r0[0], r1[0], r0[1], r1[1]}; OUT = *reinterpret_cast<bf16x8*>(&w); } while (0)
  PK4(p0, 0, pa0); PK4(p0, 8, pa1); PK4(p1, 0, pa2); PK4(p1, 8, pa3);
#undef PK4
}
__device__ __forceinline__ void qkt(f32x16& p0, f32x16& p1, const bf16* Ks, const bf16x8* qr, int r32, int hi) {
  p0 = f32x16{}; p1 = f32x16{};
  for (int d0 = 0; d0 < 8; ++d0) { int cb = (d0 * 16 + hi * 8) * 2;
    bf16x8 b0 = *reinterpret_cast<const bf16x8*>((const char*)Ks + KSWZ(r32, cb));
    bf16x8 b1 = *reinterpret_cast<const bf16x8*>((const char*)Ks + KSWZ(32 + r32, cb));
    p0 = __builtin_amdgcn_mfma_f32_32x32x16_bf16(b0, qr[d0], p0, 0, 0, 0);
    p1 = __builtin_amdgcn_mfma_f32_32x32x16_bf16(b1, qr[d0], p1, 0, 0, 0); }
}
__device__ __forceinline__ int v_st(int k, int c) { const int kk = (k & ~0xC) | ((k & 4) << 1) | ((k & 8) >> 1); return ((kk >> 3) * 4 + (c >> 5)) * 512 + ((kk & 7) * 32 + (c & 31)) * 2; }
__device__ __forceinline__ int v_rd_base(int lane) { return ((lane & 3) << 3) | (((lane >> 2) & 3) << 6) | (((lane >> 4) & 1) << 5) | (((lane >> 5) & 1) << 8); }
constexpr int v_rd_off(int d0, int ks, int half) { return d0 * 512 + ks * 4096 + half * 2048; }
template <int OFF> __device__ __forceinline__ s16x4 tr_read(int vb) {
  s16x4 r; asm volatile("ds_read_b64_tr_b16 %0, %1 offset:%2" : "=&v"(r) : "v"(vb), "i"(OFF) : "memory"); return r;
}
template <int D0> __device__ __forceinline__ void pv_one(f32x16& od, int vb, bf16x8 pa0, bf16x8 pa1, bf16x8 pa2, bf16x8 pa3) {
  const s16x4 l0 = tr_read<v_rd_off(D0, 0, 0)>(vb), h0 = tr_read<v_rd_off(D0, 0, 1)>(vb), l1 = tr_read<v_rd_off(D0, 1, 0)>(vb), h1 = tr_read<v_rd_off(D0, 1, 1)>(vb);
  const s16x4 l2 = tr_read<v_rd_off(D0, 2, 0)>(vb), h2 = tr_read<v_rd_off(D0, 2, 1)>(vb), l3 = tr_read<v_rd_off(D0, 3, 0)>(vb), h3 = tr_read<v_rd_off(D0, 3, 1)>(vb);
  asm volatile("s_waitcnt lgkmcnt(0)" ::: "memory"); SBAR();
#define PK(L, H) (bf16x8){L[0], L[1], L[2], L[3], H[0], H[1], H[2], H[3]}
  od = __builtin_amdgcn_mfma_f32_32x32x16_bf16(pa0, PK(l0, h0), od, 0, 0, 0);
  od = __builtin_amdgcn_mfma_f32_32x32x16_bf16(pa1, PK(l1, h1), od, 0, 0, 0);
  od = __builtin_amdgcn_mfma_f32_32x32x16_bf16(pa2, PK(l2, h2), od, 0, 0, 0);
  od = __builtin_amdgcn_mfma_f32_32x32x16_bf16(pa3, PK(l3, h3), od, 0, 0, 0);
#undef PK
}
__device__ __forceinline__ void pv_d0(f32x16* o, int vb, bf16x8 pa0, bf16x8 pa1, bf16x8 pa2, bf16x8 pa3) {
  pv_one<0>(o[0], vb, pa0, pa1, pa2, pa3); pv_one<1>(o[1], vb, pa0, pa1, pa2, pa3); pv_one<2>(o[2], vb, pa0, pa1, pa2, pa3); pv_one<3>(o[3], vb, pa0, pa1, pa2, pa3);
}

template <typename TQ>
__device__ __forceinline__ void attn_dense_body(const TQ* __restrict__ Qb, const bf16* __restrict__ Kh, const bf16* __restrict__ Vh,
                                                float* __restrict__ Ob, int seq, char* lds) {
  using St = Stage<bf16>; using SQ = Stage<TQ>;
  const int tid = threadIdx.x, wid = tid >> 6, lane = tid & 63, r32 = lane & 31, hi = lane >> 5;
  bf16* V_lds = (bf16*)lds; bf16* K_lds = (bf16*)(lds + 2 * SHM_V);
  float* ws = (float*)(lds + 2 * SHM_V + 2 * SHM_K) + wid * 64; float* li_l = ws; float* al_l = ws + 32;
  float m_reg = -1e30f, l_reg = 0; f32x16 o[4] = {}; bf16x8 qr[8];
  const TQ* Qw = Qb + (long)(wid * QBLK + r32) * LDQ + hi * 8;
#pragma unroll
  for (int d0 = 0; d0 < 8; ++d0) qr[d0] = SQ::tobf(SQ::ld8(Qw + d0 * 16));
  const int sr = tid >> 4, sc = (tid & 15) * 8, vst0 = v_st(sr, sc), vst1 = v_st(32 + sr, sc);
  const int vb0 = (int)(uintptr_t)V_lds + v_rd_base(lane);
  struct { typename St::T vs0, vs1, ks0, ks1; } sr_[SDEPTH];
#define SLOAD(i, k0) do { sr_[i].vs0 = St::ld8(&Vh[(long)((k0) + sr) * LDK + sc]); sr_[i].vs1 = St::ld8(&Vh[(long)((k0) + 32 + sr) * LDK + sc]); \
    sr_[i].ks0 = St::ld8(&Kh[(long)((k0) + sr) * LDK + sc]); sr_[i].ks1 = St::ld8(&Kh[(long)((k0) + 32 + sr) * LDK + sc]); } while (0)
#define SWRITE(b, i) do { *(bf16x8*)((char*)V_lds + (b) * SHM_V + vst0) = St::tobf(sr_[i].vs0);          \
    *(bf16x8*)((char*)V_lds + (b) * SHM_V + vst1) = St::tobf(sr_[i].vs1); int kc = sc * 2;               \
    *(bf16x8*)((char*)K_lds + (b) * SHM_K + KSWZ(sr, kc)) = St::tobf(sr_[i].ks0);                       \
    *(bf16x8*)((char*)K_lds + (b) * SHM_K + KSWZ(32 + sr, kc)) = St::tobf(sr_[i].ks1); } while (0)
#define SWAIT() do { if constexpr (SDEPTH == 2) asm volatile("s_waitcnt vmcnt(4)" ::: "memory"); else asm volatile("s_waitcnt vmcnt(0)" ::: "memory"); } while (0)
#define RESC(a) do { if (__any((a) < 1.f)) { if (hi == 0) al_l[r32] = (a); asm volatile("s_waitcnt lgkmcnt(0)" ::: "memory"); \
    for (int d = 0; d < 4; ++d) for (int r = 0; r < 16; ++r) o[d][r] *= al_l[crow(r, hi)]; } } while (0)
  f32x16 pA0, pA1, pB0, pB1; float mnA, mnB, alA, alB; bf16x8 pa0, pa1, pa2, pa3; const int NT = seq / KVBLK;
  constexpr int SE = 0, SO = SDEPTH - 1;
  SLOAD(SE, 0); asm volatile("s_waitcnt vmcnt(0)" ::: "memory"); SWRITE(0, SE); __syncthreads();
  qkt(pA0, pA1, K_lds, qr, r32, hi); partialSM(pA0, pA1, m_reg, mnA, alA);
  SLOAD(SO, KVBLK); if constexpr (SDEPTH == 2) { if (2 < NT) SLOAD(SE, 2 * KVBLK); }
  SWAIT(); SWRITE(1, SO); __syncthreads();
  for (int j = 1; j + 1 < NT; j += 2) {
    SBAR(); qkt(pB0, pB1, (bf16*)((char*)K_lds + SHM_K), qr, r32, hi);
    finishSM(pA0, pA1, alA, l_reg, pa0, pa1, pa2, pa3); SBAR();
    SLOAD(SO, (j + SDEPTH) * KVBLK); SBAR();
    pv_d0(o, vb0, pa0, pa1, pa2, pa3); partialSM(pB0, pB1, m_reg, mnB, alB);
    __syncthreads(); SWAIT(); SWRITE(0, SE);
    RESC(alB); __syncthreads();
    SBAR(); qkt(pA0, pA1, K_lds, qr, r32, hi);
    finishSM(pB0, pB1, alB, l_reg, pa0, pa1, pa2, pa3); SBAR();
    if (SDEPTH == 1 || j + 3 < NT) SLOAD(SE, (j + 1 + SDEPTH) * KVBLK); SBAR();
    pv_d0(o, vb0 + (int)SHM_V, pa0, pa1, pa2, pa3); partialSM(pA0, pA1, m_reg, mnA, alA);
    __syncthreads(); SWAIT(); SWRITE(1, SO);
    RESC(alA); __syncthreads();
  }
  SBAR(); qkt(pB0, pB1, (bf16*)((char*)K_lds + SHM_K), qr, r32, hi);
  finishSM(pA0, pA1, alA, l_reg, pa0, pa1, pa2, pa3); SBAR();
  pv_d0(o, vb0, pa0, pa1, pa2, pa3); partialSM(pB0, pB1, m_reg, mnB, alB);
  __syncthreads(); RESC(alB);
  finishSM(pB0, pB1, alB, l_reg, pa0, pa1, pa2, pa3); SBAR();
  pv_d0(o, vb0 + (int)SHM_V, pa0, pa1, pa2, pa3);
  if (hi == 0) li_l[r32] = l_reg; asm volatile("s_waitcnt lgkmcnt(0)" ::: "memory");
  float rli[16];
#pragma unroll
  for (int r = 0; r < 16; ++r) rli[r] = __builtin_amdgcn_rcpf(li_l[crow(r, hi)]);
  float* Ow = Ob + (long)(wid * QBLK) * LDO;
#pragma unroll
  for (int r = 0; r < 16; ++r) { int orow = crow(r, hi);
    for (int d0 = 0; d0 < 4; ++d0) Ow[(long)orow * LDO + d0 * 32 + r32] = o[d0][r] * rli[r]; }
#undef SLOAD
#undef SWRITE
#undef SWAIT
#undef RESC
}
}
namespace att2 {
using att::bf16; using att::bf16x8; using att::s16x4; using att::f32x16; using att::u32x4;
typedef __bf16 bf16x2_nat __attribute__((ext_vector_type(2)));
typedef float f32x2_nat __attribute__((ext_vector_type(2)));
__device__ __forceinline__ unsigned cvtpk_safe(float lo, float hi) { return __builtin_bit_cast(unsigned, __builtin_convertvector((f32x2_nat){lo, hi}, bf16x2_nat)); }
constexpr int L_K = 0, L_V = 32768, L_P = 98304, L_L = 131072, L_PRM = 131072 + 512, LDS_NEED = 131072 + 512 + 32;
constexpr int LDQ = 12288, LDO = 8192;
__device__ __forceinline__ int v_st2(int k, int c) { const int kk = (k & ~0xC) | ((k & 4) << 1) | ((k & 8) >> 1); return ((kk >> 3) * 8 + (c >> 5)) * 512 + ((kk & 7) * 32 + (c & 31)) * 2; }
constexpr int v_rd_off2(int d0, int ks, int half) { return d0 * 512 + ks * 8192 + half * 4096; }
template <int D0> __device__ __forceinline__ void pv_one2(f32x16& od, int vb, bf16x8 pa0, bf16x8 pa1, bf16x8 pa2, bf16x8 pa3) {
  const s16x4 l0 = att::tr_read<v_rd_off2(D0, 0, 0)>(vb), h0 = att::tr_read<v_rd_off2(D0, 0, 1)>(vb), l1 = att::tr_read<v_rd_off2(D0, 1, 0)>(vb), h1 = att::tr_read<v_rd_off2(D0, 1, 1)>(vb);
  const s16x4 l2 = att::tr_read<v_rd_off2(D0, 2, 0)>(vb), h2 = att::tr_read<v_rd_off2(D0, 2, 1)>(vb), l3 = att::tr_read<v_rd_off2(D0, 3, 0)>(vb), h3 = att::tr_read<v_rd_off2(D0, 3, 1)>(vb);
  asm volatile("s_waitcnt lgkmcnt(0)" ::: "memory"); __builtin_amdgcn_sched_barrier(0);
#define PK(L, H) (bf16x8){L[0], L[1], L[2], L[3], H[0], H[1], H[2], H[3]}
  od = __builtin_amdgcn_mfma_f32_32x32x16_bf16(pa0, PK(l0, h0), od, 0, 0, 0);
  od = __builtin_amdgcn_mfma_f32_32x32x16_bf16(pa1, PK(l1, h1), od, 0, 0, 0);
  od = __builtin_amdgcn_mfma_f32_32x32x16_bf16(pa2, PK(l2, h2), od, 0, 0, 0);
  od = __builtin_amdgcn_mfma_f32_32x32x16_bf16(pa3, PK(l3, h3), od, 0, 0, 0);
#undef PK
}
typedef float f32x4q __attribute__((ext_vector_type(4)));
#define A2_QF(R, d) __builtin_bit_cast(bf16x8, (f32x4q){R[4 * (d)], R[4 * (d) + 1], R[4 * (d) + 2], R[4 * (d) + 3]})
__device__ __forceinline__ void qkt2(f32x16& p0, f32x16& p1, const bf16* Ks, const f32x16& Qa, const f32x16& Qb, int r32, int hi) {
  p0 = f32x16{}; p1 = f32x16{};
#pragma unroll
  for (int d0 = 0; d0 < 8; ++d0) { const int cb = (d0 * 16 + hi * 8) * 2;
    const bf16x8 b0 = *reinterpret_cast<const bf16x8*>((const char*)Ks + KSWZ(r32, cb));
    const bf16x8 b1 = *reinterpret_cast<const bf16x8*>((const char*)Ks + KSWZ(32 + r32, cb));
    const bf16x8 q = d0 < 4 ? A2_QF(Qa, d0) : A2_QF(Qb, d0 - 4);
    p0 = __builtin_amdgcn_mfma_f32_32x32x16_bf16(b0, q, p0, 0, 0, 0);
    p1 = __builtin_amdgcn_mfma_f32_32x32x16_bf16(b1, q, p1, 0, 0, 0); }
}
__device__ __forceinline__ void attn_unit(const bf16* __restrict__ Qb, const bf16* __restrict__ Kh, const bf16* __restrict__ Vh, float* Ob, int seq, float kmax2, char* lds, int MAP) {
  const int tid = threadIdx.x, wid = __builtin_amdgcn_readfirstlane(tid >> 6), lane = tid & 63, r32 = lane & 31, hi = lane >> 5;
  const bool prod = wid < 4; const int pair = wid & 3;
  const int sr = tid >> 4, sc = (tid & 15) * 8;
  const int kst0 = KSWZ(sr, sc * 2), kst1 = KSWZ(32 + sr, sc * 2);
  const int vst0 = v_st2(sr, sc), vst1 = v_st2(sr, 128 + sc), vst2 = v_st2(32 + sr, sc), vst3 = v_st2(32 + sr, 128 + sc);
  const int vb0 = (int)(uintptr_t)(lds + L_V) + att::v_rd_base(lane);
  char* mbox = lds + L_P + pair * 8192 + lane * 16;
  float* lrow = (float*)(lds + L_L) + pair * 32;
  constexpr float C = att::SCALE * 1.4426950408889634f;
  const int NT = seq / 64;
  bf16x8 ks0, ks1, vs0, vs1, vs2, vs3;
#define A2_SLOAD(k0) do { const bf16* _k = Kh + (size_t)((k0) + sr) * LDQ + sc; const bf16* _v = Vh + (size_t)((k0) + sr) * LDQ + sc; \
    ks0 = *(const bf16x8*)_k; ks1 = *(const bf16x8*)(_k + (size_t)32 * LDQ); vs0 = *(const bf16x8*)_v; vs1 = *(const bf16x8*)(_v + 128); vs2 = *(const bf16x8*)(_v + (size_t)32 * LDQ); vs3 = *(const bf16x8*)(_v + (size_t)32 * LDQ + 128); } while (0)
#define A2_KWRITE(b) do { char* _kb = lds + L_K + (b) * 16384; *(bf16x8*)(_kb + kst0) = ks0; *(bf16x8*)(_kb + kst1) = ks1; } while (0)
#define A2_VWRITE(b) do { char* _vb = lds + L_V + (b) * 32768; *(bf16x8*)(_vb + vst0) = vs0; *(bf16x8*)(_vb + vst1) = vs1; *(bf16x8*)(_vb + vst2) = vs2; *(bf16x8*)(_vb + vst3) = vs3; } while (0)
#define A2_SWRITE(b) do { A2_KWRITE(b); A2_VWRITE(b); } while (0)
  if (prod) {
    asm volatile("; producer role" ::: "memory");
    A2_SLOAD(0);
    bf16x8 qr[8]; float lsum = 0.f, qn = 0.f;
    const bf16* Qw = Qb + (size_t)(pair * 32 + r32) * LDQ + hi * 8;
#pragma unroll
    for (int d0 = 0; d0 < 8; ++d0) { qr[d0] = *(const bf16x8*)(Qw + d0 * 16);
#pragma unroll
      for (int e = 0; e < 8; ++e) { const float v = __builtin_bit_cast(float, ((unsigned)(unsigned short)qr[d0][e]) << 16); qn += v * v; } }
    { auto rr = __builtin_amdgcn_permlane32_swap(__float_as_uint(qn), __float_as_uint(qn), false, false); qn = __uint_as_float(rr[0]) + __uint_as_float(rr[1]); }
    const float mC = sqrtf(qn * kmax2) * C * 1.01f;
    A2_SWRITE(0); __syncthreads();
    if (1 < NT) A2_SLOAD(64);
    for (int j = 0; j < NT; ++j) {
      f32x16 p0, p1;
      att::qkt(p0, p1, (const bf16*)(lds + L_K + (j & 1) * 16384), qr, r32, hi);
#pragma unroll
      for (int r = 0; r < 16; ++r) { p0[r] = __builtin_amdgcn_exp2f(fmaf(p0[r], C, -mC)); p1[r] = __builtin_amdgcn_exp2f(fmaf(p1[r], C, -mC)); }
      float ps = 0.f;
#pragma unroll
      for (int r = 0; r < 16; ++r) ps += p0[r] + p1[r];
      lsum += ps;
      bf16x8 pa0, pa1, pa2, pa3;
#define PK4(P, BASE, OUT) do { unsigned a0 = cvtpk_safe(P[BASE + 0], P[BASE + 1]), a1 = cvtpk_safe(P[BASE + 2], P[BASE + 3]);   \
    unsigned b0 = cvtpk_safe(P[BASE + 4], P[BASE + 5]), b1 = cvtpk_safe(P[BASE + 6], P[BASE + 7]);                              \
    auto r0 = __builtin_amdgcn_permlane32_swap(a0, b0, false, false); auto r1 = __builtin_amdgcn_permlane32_swap(a1, b1, false, false); \
    u32x4 w = {r0[0], r1[0], r0[1], r1[1]}; OUT = *reinterpret_cast<bf16x8*>(&w); } while (0)
      PK4(p0, 0, pa0); PK4(p0, 8, pa1); PK4(p1, 0, pa2); PK4(p1, 8, pa3);
#undef PK4
      char* mb = mbox + (j & 1) * 4096;
      *(bf16x8*)(mb) = pa0; *(bf16x8*)(mb + 1024) = pa1; *(bf16x8*)(mb + 2048) = pa2; *(bf16x8*)(mb + 3072) = pa3;
      if (j + 1 < NT) A2_KWRITE((j + 1) & 1);
      __syncthreads();
      if (j + 1 < NT) { A2_VWRITE((j + 1) & 1); if (j + 2 < NT) A2_SLOAD((j + 2) * 64); }
    }
    { auto rr = __builtin_amdgcn_permlane32_swap(__float_as_uint(lsum), __float_as_uint(lsum), false, false); lsum = __uint_as_float(rr[0]) + __uint_as_float(rr[1]); }
    if (hi == 0) lrow[r32] = lsum;
    __syncthreads();
  } else {
    f32x16 o[8];
#pragma unroll
    for (int d = 0; d < 8; ++d) o[d] = f32x16{};
    asm volatile("; consumer role" ::: "memory");
    A2_SLOAD(0);
    A2_SWRITE(0); __syncthreads();
    if (1 < NT) A2_SLOAD(64);
    for (int j = 0; j <= NT; ++j) {
      if (j >= 1) {
        const char* mb = mbox + ((j - 1) & 1) * 4096;
        const bf16x8 pa0 = *(const bf16x8*)(mb), pa1 = *(const bf16x8*)(mb + 1024), pa2 = *(const bf16x8*)(mb + 2048), pa3 = *(const bf16x8*)(mb + 3072);
        const int vb = vb0 + ((j - 1) & 1) * 32768;
        pv_one2<0>(o[0], vb, pa0, pa1, pa2, pa3); pv_one2<1>(o[1], vb, pa0, pa1, pa2, pa3); pv_one2<2>(o[2], vb, pa0, pa1, pa2, pa3); pv_one2<3>(o[3], vb, pa0, pa1, pa2, pa3);
        pv_one2<4>(o[4], vb, pa0, pa1, pa2, pa3); pv_one2<5>(o[5], vb, pa0, pa1, pa2, pa3); pv_one2<6>(o[6], vb, pa0, pa1, pa2, pa3); pv_one2<7>(o[7], vb, pa0, pa1, pa2, pa3);
      }
      if (j == NT) break;
      if (j + 1 < NT) A2_KWRITE((j + 1) & 1);
      __syncthreads();
      if (j + 1 < NT) { A2_VWRITE((j + 1) & 1); if (j + 2 < NT) A2_SLOAD((j + 2) * 64); }
    }
    __syncthreads();
    float* Ow = Ob + (size_t)(pair * 32) * LDO;
    int r32o = r32, hio = hi; asm volatile("" : "+v"(r32o), "+v"(hio) :: "memory");
    if (MAP == 0) {
#pragma unroll
      for (int r = 0; r < 16; ++r) { const int orow = att::crow(r, hio); const float rl = __builtin_amdgcn_rcpf(lrow[orow]);
#pragma unroll
        for (int d0 = 0; d0 < 8; ++d0) Ow[(size_t)orow * LDO + d0 * 32 + r32o] = o[d0][r] * rl; }
    } else {
      const float nl = -__uint_as_float(__builtin_amdgcn_readfirstlane(*(const unsigned*)(lds + L_PRM))), post = __uint_as_float(__builtin_amdgcn_readfirstlane(*(const unsigned*)(lds + L_PRM + 4)));
      const unsigned long long p_sg = (unsigned long long)(unsigned)__builtin_amdgcn_readfirstlane(*(const unsigned*)(lds + L_PRM + 8)) | ((unsigned long long)(unsigned)__builtin_amdgcn_readfirstlane(*(const unsigned*)(lds + L_PRM + 12)) << 32);
      const unsigned long long p_y0 = (unsigned long long)(unsigned)__builtin_amdgcn_readfirstlane(*(const unsigned*)(lds + L_PRM + 16)) | ((unsigned long long)(unsigned)__builtin_amdgcn_readfirstlane(*(const unsigned*)(lds + L_PRM + 20)) << 32);
      const unsigned long long p_a2 = (unsigned long long)(unsigned)__builtin_amdgcn_readfirstlane(*(const unsigned*)(lds + L_PRM + 24)) | ((unsigned long long)(unsigned)__builtin_amdgcn_readfirstlane(*(const unsigned*)(lds + L_PRM + 28)) << 32);
      const float* sub_gain = (const float*)p_sg;
      const size_t off = (size_t)(Ob - (float*)p_y0);
      unsigned short* Aw = (unsigned short*)p_a2 + (off >> 13) * 4096 + (off & 8191) + (size_t)(pair * 32) * 4096;
      float sg[8];
#pragma unroll
      for (int d0 = 0; d0 < 8; ++d0) sg[d0] = sub_gain[d0 * 32 + r32o];
#define A2_CMB(RG, NB) do { float o1[NB][8];                                                                                                                   \
        _Pragma("unroll") for (int k = 0; k < NB; ++k) { const int orow = att::crow(RG + k, hio);                                                               \
          _Pragma("unroll") for (int d0 = 0; d0 < 8; ++d0) o1[k][d0] = Ow[(size_t)orow * LDO + d0 * 32 + r32o]; }                                               \
        asm volatile("" ::: "memory");                                                                                                                         \
        _Pragma("unroll") for (int k = 0; k < NB; ++k) { const int r = RG + k; const int orow = att::crow(r, hio);                                              \
          float dv[8], ss = 0.f; float rl = __builtin_amdgcn_rcpf(lrow[orow]); asm volatile("" : "+v"(rl));                                                     \
          _Pragma("unroll") for (int d0 = 0; d0 < 8; ++d0) { dv[d0] = fmaf(nl, o[d0][r] * rl, o1[k][d0]); ss += dv[d0] * dv[d0]; }                              \
          ss += __shfl_xor(ss, 1); ss += __shfl_xor(ss, 2); ss += __shfl_xor(ss, 4); ss += __shfl_xor(ss, 8); ss += __shfl_xor(ss, 16);                          \
          const float rs = rsqrtf(ss * (1.f / 256.f) + 1e-6f) * post;                                                                                          \
          _Pragma("unroll") for (int d0 = 0; d0 < 8; ++d0) { const float w = dv[d0] * rs * sg[d0]; Aw[(size_t)orow * 4096 + d0 * 32 + r32o] = (unsigned short)(cvtpk_safe(w, w) & 0xffffu); } } \
        asm volatile("" ::: "memory"); } while (0)
      A2_CMB(0, 2); A2_CMB(2, 2); A2_CMB(4, 2); A2_CMB(6, 2); A2_CMB(8, 4); A2_CMB(12, 4);
#undef A2_CMB
    }
  }
  __syncthreads();
#undef A2_SLOAD
#undef A2_SWRITE
#undef A2_KWRITE
#undef A2_VWRITE
}
}
constexpr int NWAVES = 8;
constexpr int DM = 4096, TL = 8192, TC = 256, TT = TL + TC, DEPTH = 4;
constexpr int MODW = 6 * DM;
constexpr int SSD_ZXW = 18432, SSD_INC = 18688, SSD_CC = 10240;
constexpr float RMS_EPS = 1e-6f;
typedef unsigned short bf16;
typedef unsigned v4u __attribute__((ext_vector_type(4)));
typedef unsigned v2u __attribute__((ext_vector_type(2)));
typedef float f32x4 __attribute__((ext_vector_type(4)));
typedef float f32x2 __attribute__((ext_vector_type(2)));
#define LAS __attribute__((address_space(3)))

constexpr size_t MiB = 1u << 20;
constexpr size_t al256(size_t x) { return (x + 255) & ~(size_t)255; }
constexpr size_t WS_CTL = 0, CTL_BYTES = 1 * MiB;
constexpr size_t WS_MOD = WS_CTL + CTL_BYTES;
constexpr size_t WS_ROPE = WS_MOD + al256((size_t)DEPTH * 2 * MODW * 4);
constexpr size_t WS_WUP = WS_ROPE + al256(128 * 32 * 2 * 4);
constexpr size_t WS_WDN = WS_WUP + (size_t)4 * 8192 * 4096 * 2;
constexpr size_t WS_WSI = WS_WDN + (size_t)4 * 4096 * 4096 * 2;
constexpr size_t WS_WSO = WS_WSI + (size_t)2 * 18688 * 4096 * 2;
constexpr size_t WS_WGL = WS_WSO + (size_t)2 * 4096 * 8192 * 2;
constexpr size_t WS_WQKV = WS_WGL + (size_t)8192 * 4096 * 2;
constexpr size_t WS_WO = WS_WQKV + (size_t)12288 * 4096 * 2;
constexpr size_t WS_X = WS_WO + (size_t)4096 * 4096 * 2;
constexpr size_t WS_H = WS_X + (size_t)TT * DM * 4;
constexpr size_t WS_BIG = WS_H + (size_t)TT * DM * 2;
constexpr size_t WS_DT = WS_BIG + (size_t)TT * SSD_ZXW * 2;
constexpr size_t WS_XBC = WS_DT + (size_t)TT * 256 * 4;
constexpr size_t WS_Y0 = WS_XBC + (size_t)TT * SSD_CC * 2;
constexpr size_t WS_Y1 = WS_Y0 + (size_t)TT * 8192 * 4;
constexpr size_t WS_A2 = WS_Y1 + (size_t)TT * 8192 * 4;
constexpr size_t WS_END = WS_A2 + (size_t)TT * 8192 * 2;
constexpr int CW_BAR = 4096, CW_KMAX = 16384;

constexpr int RING_BYTES = 131072, LDSCTL_OFF = 146432, MISC_OFF = LDSCTL_OFF + 320, LDS_BYTES = 147456;

__device__ __forceinline__ float bf2f(unsigned b) { return __builtin_bit_cast(float, b << 16); }
__device__ __forceinline__ float bflo(unsigned w) { return __builtin_bit_cast(float, w << 16); }
__device__ __forceinline__ float bfhi(unsigned w) { return __builtin_bit_cast(float, w & 0xffff0000u); }
__device__ __forceinline__ unsigned pk2(float lo, float hi) { return pg8::cvt_pk_bf16(lo, hi); }
__device__ __forceinline__ float wave_sum(float v) {
#pragma unroll
    for (int o = 1; o < 64; o <<= 1) v += __shfl_xor(v, o);
    return v;
}
__device__ __forceinline__ float silu_f(float x) { return x * __builtin_amdgcn_rcpf(1.f + __expf(-x)); }
__device__ __forceinline__ float sigmoid_f(float x) { return __builtin_amdgcn_rcpf(1.f + __expf(-x)); }
__device__ __forceinline__ float gelu_tanh_f(float x) { const float z = 0.7978845608028654f * (x + 0.044715f * x * x * x); return x * __builtin_amdgcn_rcpf(1.f + __expf(-2.f * z)); }
#define LDS_WAIT() asm volatile("s_waitcnt lgkmcnt(0)" ::: "memory")

#define XB_TMO      128
#define XB_XCNT(j)  (256  + 64 * (j))
#define XB_XSUB(j)  (1280 + 64 * (j))
#define XB_XGEN(j)  (2304 + 64 * (j))
#define XB_TOP      3328
#define XB_TOPGEN   3392
#define XCD_BAR_WORDS 3456
#define XB_SPIN_CAP (1u << 18)

__device__ __forceinline__ unsigned xb_ld(unsigned* p)              { return __hip_atomic_load(p, __ATOMIC_RELAXED, __HIP_MEMORY_SCOPE_AGENT); }
__device__ __forceinline__ unsigned xb_add(unsigned* p, unsigned v) { return __hip_atomic_fetch_add(p, v, __ATOMIC_RELAXED, __HIP_MEMORY_SCOPE_AGENT); }
__device__ __forceinline__ unsigned xb_xcc_id() { return (unsigned)__builtin_amdgcn_s_getreg((3 << 11) | 20) & 0xFu; }
#define XB_SPIN(cond, bar) do { unsigned _sp = 0; while (cond) { __builtin_amdgcn_s_sleep(1); \
    if ((++_sp & 255u) == 0u) { if (xb_ld(&(bar)[XB_TMO])) break; if (_sp > XB_SPIN_CAP) { atomicAdd(&(bar)[XB_TMO], 1u); break; } } } } while (0)

struct XcdBarrier {
    unsigned* bar; unsigned x;
    volatile LAS unsigned* st;
};

__device__ __forceinline__ XcdBarrier xcd_barrier_post(unsigned* bar, volatile LAS unsigned* st) {
    XcdBarrier b; b.bar = bar; b.x = xb_xcc_id(); b.st = st;
    if (threadIdx.x == 0) (void)xb_add(&bar[XB_XCNT(b.x)], 1u);
    return b;
}
__device__ __forceinline__ void xcd_barrier_complete(unsigned* bar, unsigned x, unsigned& nloc, unsigned& nx) {
    const unsigned G = gridDim.x * gridDim.y * gridDim.z;
    unsigned sum, cnt, mine, sp = 0u;
    for (;;) {
        sum = 0u; cnt = 0u; mine = 0u;
#pragma unroll
        for (unsigned j = 0; j < 16; ++j) { const unsigned c = xb_ld(&bar[XB_XCNT(j)]); sum += c; cnt += (c > 0u) ? 1u : 0u; mine = (j == x) ? c : mine; }
        if (sum == G) break;
        __builtin_amdgcn_s_sleep(1);
        if ((++sp & 255u) == 0u) { if (xb_ld(&bar[XB_TMO])) break; if (sp > XB_SPIN_CAP) { atomicAdd(&bar[XB_TMO], 1u); break; } }
    }
    nloc = mine > 0u ? mine : 1u; nx = cnt > 0u ? cnt : 1u;
}

__device__ __forceinline__ void xcd_barrier(const XcdBarrier& b) {
    asm volatile("s_waitcnt vmcnt(0)" ::: "memory");
    __syncthreads();
    if (threadIdx.x == 0) {
        unsigned* bar = b.bar;
        __builtin_amdgcn_s_waitcnt(0);
        unsigned nloc = b.st[0], nx = b.st[1];
        if (nloc == 0u) { xcd_barrier_complete(bar, b.x, nloc, nx); b.st[0] = nloc; b.st[1] = nx; }
        const unsigned old = xb_add(&bar[XB_XSUB(b.x)], 1u);
        const unsigned gen = old / nloc;
        if (old + 1u == (gen + 1u) * nloc) {
            __builtin_amdgcn_fence(__ATOMIC_RELEASE, "agent");
            asm volatile("s_waitcnt vmcnt(0)" ::: "memory");
            const unsigned og = xb_add(&bar[XB_TOP], 1u);
            const unsigned tg = og / nx;
            if (og + 1u == (tg + 1u) * nx) xb_add(&bar[XB_TOPGEN], 1u);
            else XB_SPIN(xb_ld(&bar[XB_TOPGEN]) == tg, bar);
            __builtin_amdgcn_fence(__ATOMIC_ACQUIRE, "agent");
            xb_add(&bar[XB_XGEN(b.x)], 1u);
            asm volatile("s_waitcnt vmcnt(0)" ::: "memory");
        } else {
            XB_SPIN(xb_ld(&bar[XB_XGEN(b.x)]) == gen, bar);
            __builtin_amdgcn_fence(__ATOMIC_ACQUIRE, "agent");
            asm volatile("s_waitcnt vmcnt(0)" ::: "memory");
        }
    }
    __syncthreads();
}

__device__ __forceinline__ void transpose_item(const float* W, int K, int N, bf16* WT, int row_off, LAS float* scr, int item, int lane) {
    const int nblk = N / 32, kb = item / nblk, nb = item % nblk, k0 = 64 * kb, n0 = 32 * nb;
    float tv[32];
#pragma unroll
    for (int i = 0; i < 32; ++i) tv[i] = W[(size_t)(k0 + 2 * i + (lane >> 5)) * N + n0 + (lane & 31)];
#pragma unroll
    for (int i = 0; i < 32; ++i) scr[(2 * i + (lane >> 5)) * 33 + (lane & 31)] = tv[i];
    LDS_WAIT(); asm volatile("" ::: "memory");
    const int c = lane & 7;
#pragma unroll
    for (int j = 0; j < 4; ++j) { const int n = (lane >> 3) + 8 * j; const LAS float* s = scr + (8 * c) * 33 + n;
        v4u o; o.x = pk2(s[0 * 33], s[1 * 33]); o.y = pk2(s[2 * 33], s[3 * 33]); o.z = pk2(s[4 * 33], s[5 * 33]); o.w = pk2(s[6 * 33], s[7 * 33]);
        *(v4u*)(WT + (size_t)(row_off + n0 + n) * K + k0 + 8 * c) = o; }
    LDS_WAIT(); asm volatile("" ::: "memory");
}
__device__ __forceinline__ void transpose_matrix(const float* W, int K, int N, bf16* WT, int row_off, LAS float* scr, int gw, int NGW, int lane) {
    const int nitems = (K / 64) * (N / 32);
    for (int it = gw; it < nitems; it += NGW) transpose_item(W, K, N, WT, row_off, scr, it, lane);
}

__device__ __forceinline__ void mod_phase(const float* c_lat, const float* c_ctx, const float* mod_w, const float* mod_b, float* MOD, LAS unsigned char* lds, int tid, int wave, int lane) {
    LAS float* S = (LAS float*)lds;
    LAS float* RED = (LAS float*)(lds + 32768);
    for (int k = tid; k < DM; k += NWAVES * 64) { S[k] = silu_f(c_lat[k]); S[DM + k] = silu_f(c_ctx[k]); }
    __syncthreads();
    for (int item = blockIdx.x; item < DEPTH * 192; item += gridDim.x) {
        const int l = item / 192, n0 = (item % 192) * 128;
        const float* W = mod_w + (size_t)l * DM * MODW + n0 + 2 * lane;
        f32x2 a0 = {0.f, 0.f}, a1 = {0.f, 0.f};
        const int kb = wave * 512;
#pragma unroll 16
        for (int k = 0; k < 512; ++k) { const f32x2 wv = *(const f32x2*)(W + (size_t)(kb + k) * MODW); const float s0 = S[kb + k], s1 = S[DM + kb + k]; a0 += wv * s0; a1 += wv * s1; }
        RED[(wave * 2 + 0) * 128 + 2 * lane] = a0.x; RED[(wave * 2 + 0) * 128 + 2 * lane + 1] = a0.y;
        RED[(wave * 2 + 1) * 128 + 2 * lane] = a1.x; RED[(wave * 2 + 1) * 128 + 2 * lane + 1] = a1.y;
        __syncthreads();
        if (tid < 256) { const int v = tid >> 7, n = tid & 127; float s = 0.f;
#pragma unroll
            for (int w = 0; w < 8; ++w) s += RED[(w * 2 + v) * 128 + n];
            MOD[(size_t)(l * 2 + v) * MODW + n0 + n] = s + mod_b[(size_t)l * MODW + n0 + n]; }
        __syncthreads();
    }
}

__device__ __forceinline__ void norm_mod_phase(const bf16* X, const float* gain, const float* modL, int sh_off, int sc_off, bf16* H, int gw, int NGW, int lane, const float* Xc = nullptr, const float* Xl = nullptr) {
    const int NMAIN = (TT / NGW) * NGW;
    for (int r = gw; r < NMAIN; r += NGW) {
        f32x4 v[8][2]; float ss = 0.f;
        if (Xl) { const float* xr = r < TC ? Xc + (size_t)r * DM : Xl + (size_t)(r - TC) * DM;
#pragma unroll
            for (int j = 0; j < 8; ++j) { v[j][0] = *(const f32x4*)(xr + 8 * (lane + 64 * j)); v[j][1] = *(const f32x4*)(xr + 8 * (lane + 64 * j) + 4); }
        } else { const bf16* xr = X + (size_t)r * DM; v4u xb[8];
#pragma unroll
            for (int j = 0; j < 8; ++j) xb[j] = *(const v4u*)(xr + 8 * (lane + 64 * j));
#pragma unroll
            for (int j = 0; j < 8; ++j) { v[j][0] = f32x4{bflo(xb[j].x), bfhi(xb[j].x), bflo(xb[j].y), bfhi(xb[j].y)}; v[j][1] = f32x4{bflo(xb[j].z), bfhi(xb[j].z), bflo(xb[j].w), bfhi(xb[j].w)}; } }
#pragma unroll
        for (int j = 0; j < 8; ++j)
#pragma unroll
            for (int h = 0; h < 2; ++h) ss += (v[j][h].x * v[j][h].x + v[j][h].y * v[j][h].y) + (v[j][h].z * v[j][h].z + v[j][h].w * v[j][h].w);
        ss = wave_sum(ss); const float rs = rsqrtf(ss * (1.f / DM) + RMS_EPS);
        const float* md = modL + (r < TC ? MODW : 0);
#pragma unroll
        for (int j = 0; j < 8; ++j) { const int c = 8 * (lane + 64 * j);
            f32x4 o[2];
#pragma unroll
            for (int h = 0; h < 2; ++h) { const f32x4 g = *(const f32x4*)(gain + c + 4 * h), sc = *(const f32x4*)(md + sc_off + c + 4 * h), sh = *(const f32x4*)(md + sh_off + c + 4 * h);
                o[h] = (v[j][h] * rs) * g * (sc + 1.f) + sh; }
            v4u w; w.x = pk2(o[0].x, o[0].y); w.y = pk2(o[0].z, o[0].w); w.z = pk2(o[1].x, o[1].y); w.w = pk2(o[1].z, o[1].w); *(v4u*)(H + (size_t)r * DM + c) = w; }
    }
    {
        extern __shared__ __attribute__((aligned(16))) unsigned char lds_norm_raw[];
        LAS float* red = (LAS float*)((LAS unsigned char*)lds_norm_raw + LDSCTL_OFF);
        const int wv = gw & (NWAVES - 1), wg = blockIdx.x, nwg = NGW / NWAVES;
        for (int r = NMAIN + wg; r < TT; r += nwg) {
            const int c0 = 512 * wv + 4 * lane;
            f32x4 v0, v1;
            if (Xl) { const float* xr = r < TC ? Xc + (size_t)r * DM : Xl + (size_t)(r - TC) * DM; v0 = *(const f32x4*)(xr + c0); v1 = *(const f32x4*)(xr + c0 + 256); }
            else { const bf16* xr = X + (size_t)r * DM; const v2u b0 = *(const v2u*)(xr + c0), b1 = *(const v2u*)(xr + c0 + 256);
                v0 = f32x4{bflo(b0.x), bfhi(b0.x), bflo(b0.y), bfhi(b0.y)}; v1 = f32x4{bflo(b1.x), bfhi(b1.x), bflo(b1.y), bfhi(b1.y)}; }
            float ss = wave_sum((v0.x * v0.x + v0.y * v0.y) + (v0.z * v0.z + v0.w * v0.w) + (v1.x * v1.x + v1.y * v1.y) + (v1.z * v1.z + v1.w * v1.w));
            __syncthreads();
            if (lane == 0) red[wv] = ss;
            __syncthreads();
            float tot = 0.f;
#pragma unroll
            for (int k = 0; k < NWAVES; ++k) tot += red[k];
            const float rs = rsqrtf(tot * (1.f / DM) + RMS_EPS);
            const float* md = modL + (r < TC ? MODW : 0);
#pragma unroll
            for (int h = 0; h < 2; ++h) { const int c = c0 + 256 * h; const f32x4 vv = h ? v1 : v0;
                const f32x4 g = *(const f32x4*)(gain + c), sc = *(const f32x4*)(md + sc_off + c), sh = *(const f32x4*)(md + sh_off + c);
                const f32x4 o = (vv * rs) * g * (sc + 1.f) + sh;
                v2u w; w.x = pk2(o.x, o.y); w.y = pk2(o.z, o.w); *(v2u*)(H + (size_t)r * DM + c) = w; }
        }
    }
}

__device__ __forceinline__ void ssd_conv_phase(const bf16* __restrict__ ZX, const float* __restrict__ cw, const float* __restrict__ cb, bf16* __restrict__ XBC, int gw, int NGW, int lane) {
    constexpr int NRB = TT / 8, NCB = SSD_CC / 512;
    const int nwv = NGW / NCB;
    f32x2 w[5][4], b[4];
    int cbk_have = -1;
    const int it_step = nwv >= 1 ? nwv * NCB : NGW;
    if (nwv >= 1 && gw >= nwv * NCB) return;
    for (int it = gw; it < NRB * NCB; it += it_step) {
        const int rb = it / NCB, cbk = it % NCB, r0 = rb * 8, c = cbk * 512 + lane * 8;
        const int seg_lo = (r0 < TC) ? 0 : TC, seg_hi = (r0 < TC) ? TC : TT;
        v4u win[12];
#pragma unroll
        for (int j = 0; j < 12; ++j) win[j] = (v4u){0u, 0u, 0u, 0u};
        if (r0 - 2 >= seg_lo && r0 + 10 <= seg_hi) {
#pragma unroll
            for (int j = 0; j < 12; ++j) win[j] = *(const v4u*)(ZX + (size_t)(r0 - 2 + j) * SSD_ZXW + 8192 + c);
        } else {
#pragma unroll
            for (int j = 0; j < 12; ++j) { const int rr = r0 - 2 + j; if (rr >= seg_lo && rr < seg_hi) win[j] = *(const v4u*)(ZX + (size_t)rr * SSD_ZXW + 8192 + c); } }
        if (cbk != cbk_have) { cbk_have = cbk;
#pragma unroll
            for (int j = 0; j < 5; ++j) { const f32x4 a0 = *(const f32x4*)(cw + (size_t)j * SSD_CC + c), a1 = *(const f32x4*)(cw + (size_t)j * SSD_CC + c + 4);
                w[j][0] = f32x2{a0.x, a0.y}; w[j][1] = f32x2{a0.z, a0.w}; w[j][2] = f32x2{a1.x, a1.y}; w[j][3] = f32x2{a1.z, a1.w}; }
            { const f32x4 a0 = *(const f32x4*)(cb + c), a1 = *(const f32x4*)(cb + c + 4); b[0] = f32x2{a0.x, a0.y}; b[1] = f32x2{a0.z, a0.w}; b[2] = f32x2{a1.x, a1.y}; b[3] = f32x2{a1.z, a1.w}; } }
#pragma unroll
        for (int i = 0; i < 8; ++i) {
            f32x2 o[4];
#pragma unroll
            for (int q = 0; q < 4; ++q) o[q] = b[q];
#pragma unroll
            for (int j = 0; j < 5; ++j) {
#pragma unroll
                for (int q = 0; q < 4; ++q) o[q] += w[j][q] * f32x2{bflo(win[i + j][q]), bfhi(win[i + j][q])}; }
            v4u ov; ov.x = pk2(silu_f(o[0].x), silu_f(o[0].y)); ov.y = pk2(silu_f(o[1].x), silu_f(o[1].y)); ov.z = pk2(silu_f(o[2].x), silu_f(o[2].y)); ov.w = pk2(silu_f(o[3].x), silu_f(o[3].y));
            *(v4u*)(XBC + (size_t)(r0 + i) * SSD_CC + c) = ov; }
    }
}

__device__ __forceinline__ void ffn_conv_phase(const bf16* __restrict__ U, const float* __restrict__ cw, const float* __restrict__ cb, bf16* __restrict__ G, int gw, int NGW, int lane) {
    constexpr int NRB = TT / 8, NCB = 4096 / 512;
    f32x2 wg[3][4], wv[3][4], bg[4], bv[4];
    int cbk_have = -1;
    for (int it = gw; it < NRB * NCB; it += NGW) {
        const int rb = it / NCB, cbk = it % NCB, r0 = rb * 8, c = cbk * 512 + lane * 8;
        const int seg_lo = (r0 < TC) ? 0 : TC, seg_hi = (r0 < TC) ? TC : TT;
        v4u wing[10], winv[10];
#pragma unroll
        for (int j = 0; j < 10; ++j) { wing[j] = (v4u){0u, 0u, 0u, 0u}; winv[j] = (v4u){0u, 0u, 0u, 0u}; }
        if (r0 - 1 >= seg_lo && r0 + 9 <= seg_hi) {
#pragma unroll
            for (int j = 0; j < 10; ++j) { wing[j] = *(const v4u*)(U + (size_t)(r0 - 1 + j) * 8192 + c); winv[j] = *(const v4u*)(U + (size_t)(r0 - 1 + j) * 8192 + 4096 + c); }
        } else {
#pragma unroll
            for (int j = 0; j < 10; ++j) { const int rr = r0 - 1 + j; if (rr >= seg_lo && rr < seg_hi) { wing[j] = *(const v4u*)(U + (size_t)rr * 8192 + c); winv[j] = *(const v4u*)(U + (size_t)rr * 8192 + 4096 + c); } } }
        if (cbk != cbk_have) { cbk_have = cbk;
#pragma unroll
        for (int j = 0; j < 3; ++j) {
            const f32x4 a0 = *(const f32x4*)(cw + (size_t)j * 8192 + c), a1 = *(const f32x4*)(cw + (size_t)j * 8192 + c + 4);
            const f32x4 d0 = *(const f32x4*)(cw + (size_t)j * 8192 + 4096 + c), d1 = *(const f32x4*)(cw + (size_t)j * 8192 + 4096 + c + 4);
            wg[j][0] = f32x2{a0.x, a0.y}; wg[j][1] = f32x2{a0.z, a0.w}; wg[j][2] = f32x2{a1.x, a1.y}; wg[j][3] = f32x2{a1.z, a1.w};
            wv[j][0] = f32x2{d0.x, d0.y}; wv[j][1] = f32x2{d0.z, d0.w}; wv[j][2] = f32x2{d1.x, d1.y}; wv[j][3] = f32x2{d1.z, d1.w}; }
        { const f32x4 a0 = *(const f32x4*)(cb + c), a1 = *(const f32x4*)(cb + c + 4), d0 = *(const f32x4*)(cb + 4096 + c), d1 = *(const f32x4*)(cb + 4096 + c + 4);
          bg[0] = f32x2{a0.x, a0.y}; bg[1] = f32x2{a0.z, a0.w}; bg[2] = f32x2{a1.x, a1.y}; bg[3] = f32x2{a1.z, a1.w};
          bv[0] = f32x2{d0.x, d0.y}; bv[1] = f32x2{d0.z, d0.w}; bv[2] = f32x2{d1.x, d1.y}; bv[3] = f32x2{d1.z, d1.w}; } }
#pragma unroll
        for (int i = 0; i < 8; ++i) {
            f32x2 og[4], ov[4];
#pragma unroll
            for (int q = 0; q < 4; ++q) { og[q] = bg[q]; ov[q] = bv[q]; }
#pragma unroll
            for (int j = 0; j < 3; ++j) {
#pragma unroll
                for (int q = 0; q < 4; ++q) { og[q] += wg[j][q] * f32x2{bflo(wing[i + j][q]), bfhi(wing[i + j][q])}; ov[q] += wv[j][q] * f32x2{bflo(winv[i + j][q]), bfhi(winv[i + j][q])}; } }
            v4u o; o.x = pk2(silu_f(og[0].x) * ov[0].x, silu_f(og[0].y) * ov[0].y); o.y = pk2(silu_f(og[1].x) * ov[1].x, silu_f(og[1].y) * ov[1].y);
            o.z = pk2(silu_f(og[2].x) * ov[2].x, silu_f(og[2].y) * ov[2].y); o.w = pk2(silu_f(og[3].x) * ov[3].x, silu_f(og[3].y) * ov[3].y);
            *(v4u*)(G + (size_t)(r0 + i) * 4096 + c) = o; }
    }
}

typedef short bf16x8_t __attribute__((ext_vector_type(8)));
typedef short s16x4_t __attribute__((ext_vector_type(4)));
constexpr int SS_RS = 272, SS_RX = 144;
constexpr int SS_BT = 0, SS_CT = 34816, SS_BW = 69632, SS_XN = 104448, SS_HT = 122880, SS_CUM = 141312;
static_assert(SS_CUM + 4096 <= LDSCTL_OFF, "SSD scan LDS map");
__device__ __forceinline__ int ssd_chunk_base(int dir, int j) { return dir == 0 ? 128 * j : (j < 2 ? TC - 128 * (j + 1) : TT - 128 * (j - 1)); }
template <int OFF> __device__ __forceinline__ v2u tr_read8(unsigned addr) { v2u r; asm volatile("ds_read_b64_tr_b16 %0, %1 offset:%2" : "=&v"(r) : "v"(addr), "i"(OFF) : "memory"); return r; }
__device__ __forceinline__ v2u tr_read8_dyn(unsigned addr, int off) { v2u r; asm volatile("ds_read_b64_tr_b16 %0, %1 offset:%2" : "=&v"(r) : "v"(addr), "n"(off) : "memory"); return r; }
#define SS_LGKM_WAIT() do { asm volatile("s_waitcnt lgkmcnt(0)" ::: "memory"); __builtin_amdgcn_sched_barrier(0); } while (0)
__device__ __forceinline__ void ssd_scan_phase(const bf16* XBC, const float* DT, const float* a_log, const float* d_skip, bf16* YF, bf16* YB, LAS unsigned char* lds, int tid) {
    const int lane = tid & 63, w = __builtin_amdgcn_readfirstlane(tid >> 6), wq = tid >> 6, i = lane & 15, q = lane >> 4;
    const int srow = tid >> 2, sseg = tid & 3;
    const int tq = (lane >> 2) & 3, tp = lane & 3;
    const unsigned ldsb = (unsigned)(size_t)lds;
    const unsigned trb_x4 = ldsb + SS_XN + (4 * q + tq) * SS_RX + 8 * tp, trb_x8 = ldsb + SS_XN + (8 * q + tq) * SS_RX + 8 * tp;
    const unsigned trb_h8 = ldsb + SS_HT + (8 * q + tq) * SS_RX + 8 * tp, trb_b8 = ldsb + SS_BW + (8 * q + tq) * SS_RS + (16 * wq + 4 * tp) * 2;
    for (int u = blockIdx.x; u < 256; u += gridDim.x) {
        const int dir = u >> 7, head = u & 127, g = head >> 4;
        const float a = -__expf(a_log[dir * 128 + head]);
        const float dsk = d_skip[head];
        bf16* Y = dir ? YB : YF;
        f32x4 Hm[4];
#pragma unroll
        for (int pt = 0; pt < 4; ++pt) Hm[pt] = (f32x4){0.f, 0.f, 0.f, 0.f};
        float pen[4];
#pragma unroll
        for (int r = 0; r < 4; ++r) pen[r] = (dir ? (4 * q + r >= i) : (4 * q + r <= i)) ? 0.f : -1e30f;
        v4u rb[4], rc[4], rx[2]; float rd0 = 0.f, rd1 = 0.f;
        const int e0 = dir ? 127 - 2 * lane : 2 * lane, e1 = dir ? e0 - 1 : e0 + 1;
#define SSD_LOAD(j) do { const int _b = ssd_chunk_base(dir, (j)); const bf16* _p = XBC + (size_t)(_b + srow) * SSD_CC; \
        _Pragma("unroll") for (int k = 0; k < 4; ++k) { rb[k] = *(const v4u*)(_p + 8192 + g * 128 + sseg * 32 + 8 * k); rc[k] = *(const v4u*)(_p + 9216 + g * 128 + sseg * 32 + 8 * k); } \
        rx[0] = *(const v4u*)(_p + head * 64 + sseg * 16); rx[1] = *(const v4u*)(_p + head * 64 + sseg * 16 + 8); \
        if (w == 0) { rd0 = DT[(size_t)(_b + e0) * 256 + dir * 128 + head]; rd1 = DT[(size_t)(_b + e1) * 256 + dir * 128 + head]; } } while (0)
#define SSD_SCAN(jb) do { LAS float* _c = (LAS float*)(lds + SS_CUM + (jb) * 2048); const float v0 = rd0 * a, v1 = rd1 * a; float inc = v0 + v1; \
        _Pragma("unroll") for (int o = 1; o < 64; o <<= 1) { const float t = __shfl_up(inc, o); if (lane >= o) inc += t; } \
        const float c0 = inc - v1, c1 = inc; const float total = __shfl(inc, 63); \
        _c[e0] = c0; _c[e1] = c1; _c[128 + e0] = rd0; _c[128 + e1] = rd1; _c[256 + e0] = rd0 * __expf(total - c0); _c[256 + e1] = rd1 * __expf(total - c1); \
        if (lane == 0) _c[384] = total; } while (0)
        SSD_LOAD(0);
        if (w == 0) SSD_SCAN(0);
        for (int j = 0; j < 66; ++j) {
            const int base = ssd_chunk_base(dir, j);
            LAS float* cum = (LAS float*)(lds + SS_CUM + (j & 1) * 2048); LAS float* dtv = cum + 128; LAS float* wv = cum + 256; LAS float* tot = cum + 384;
            __syncthreads();
#pragma unroll
            for (int pt = 0; pt < 4; ++pt) { v2u hp; hp.x = pk2(Hm[pt][0], Hm[pt][1]); hp.y = pk2(Hm[pt][2], Hm[pt][3]);
                *(LAS v2u*)(lds + SS_HT + (16 * wq + i) * SS_RX + (16 * pt + 4 * q) * 2) = hp; }
            { const float wl = wv[srow];
#pragma unroll
              for (int k = 0; k < 4; ++k) { *(LAS v4u*)(lds + SS_BT + srow * SS_RS + (sseg * 32 + 8 * k) * 2) = rb[k]; *(LAS v4u*)(lds + SS_CT + srow * SS_RS + (sseg * 32 + 8 * k) * 2) = rc[k];
                  v4u bw;
#pragma unroll
                  for (int e = 0; e < 4; ++e) bw[e] = pk2(bflo(rb[k][e]) * wl, bfhi(rb[k][e]) * wl);
                  *(LAS v4u*)(lds + SS_BW + srow * SS_RS + (sseg * 32 + 8 * k) * 2) = bw; } }
            *(LAS v4u*)(lds + SS_XN + srow * SS_RX + (sseg * 16) * 2) = rx[0]; *(LAS v4u*)(lds + SS_XN + srow * SS_RX + (sseg * 16 + 8) * 2) = rx[1];
            __syncthreads();
            if (j + 1 < 66) SSD_LOAD(j + 1);
            bf16x8_t cf[4];
#pragma unroll
            for (int kk = 0; kk < 4; ++kk) cf[kk] = *(const LAS bf16x8_t*)(lds + SS_CT + (16 * wq + i) * SS_RS + (32 * kk + 8 * q) * 2);
            const float cl = cum[16 * wq + i];
            f32x4 accd[4], acco[4];
#pragma unroll
            for (int pt = 0; pt < 4; ++pt) { accd[pt] = (f32x4){0.f, 0.f, 0.f, 0.f}; acco[pt] = (f32x4){0.f, 0.f, 0.f, 0.f}; }
#pragma unroll
            for (int ks = 0; ks < 4; ++ks) {
                const int st0 = 2 * ks, st1 = 2 * ks + 1;
                const bool need0 = dir ? (st0 >= w) : (st0 <= w), need1 = dir ? (st1 >= w) : (st1 <= w);
                if (!need0 && !need1) continue;
                v2u xa[4], xc[4];
#pragma unroll
                for (int pt = 0; pt < 4; ++pt) { xa[pt] = tr_read8_dyn(trb_x4, 32 * ks * SS_RX + 32 * pt); xc[pt] = tr_read8_dyn(trb_x4, (32 * ks + 16) * SS_RX + 32 * pt); }
                f32x4 g0 = (f32x4){0.f, 0.f, 0.f, 0.f}, g1 = (f32x4){0.f, 0.f, 0.f, 0.f};
                if (need0) {
#pragma unroll
                    for (int kk = 0; kk < 4; ++kk) { const bf16x8_t ab = *(const LAS bf16x8_t*)(lds + SS_BT + (16 * st0 + i) * SS_RS + (32 * kk + 8 * q) * 2); g0 = __builtin_amdgcn_mfma_f32_16x16x32_bf16(ab, cf[kk], g0, 0, 0, 0); }
                    const f32x4 cs = *(const LAS f32x4*)(cum + 16 * st0 + 4 * q), ds = *(const LAS f32x4*)(dtv + 16 * st0 + 4 * q);
                    if (st0 == w) {
#pragma unroll
                        for (int r = 0; r < 4; ++r) g0[r] = g0[r] * __expf(cl - cs[r] + pen[r]) * ds[r];
                    } else {
#pragma unroll
                        for (int r = 0; r < 4; ++r) g0[r] = g0[r] * __expf(cl - cs[r]) * ds[r];
                    }
                }
                if (need1) {
#pragma unroll
                    for (int kk = 0; kk < 4; ++kk) { const bf16x8_t ab = *(const LAS bf16x8_t*)(lds + SS_BT + (16 * st1 + i) * SS_RS + (32 * kk + 8 * q) * 2); g1 = __builtin_amdgcn_mfma_f32_16x16x32_bf16(ab, cf[kk], g1, 0, 0, 0); }
                    const f32x4 cs = *(const LAS f32x4*)(cum + 16 * st1 + 4 * q), ds = *(const LAS f32x4*)(dtv + 16 * st1 + 4 * q);
                    if (st1 == w) {
#pragma unroll
                        for (int r = 0; r < 4; ++r) g1[r] = g1[r] * __expf(cl - cs[r] + pen[r]) * ds[r];
                    } else {
#pragma unroll
                        for (int r = 0; r < 4; ++r) g1[r] = g1[r] * __expf(cl - cs[r]) * ds[r];
                    }
                }
                v4u amw; amw.x = pk2(g0[0], g0[1]); amw.y = pk2(g0[2], g0[3]); amw.z = pk2(g1[0], g1[1]); amw.w = pk2(g1[2], g1[3]);
                const bf16x8_t am = __builtin_bit_cast(bf16x8_t, amw);
                SS_LGKM_WAIT();
#pragma unroll
                for (int pt = 0; pt < 4; ++pt) { v4u xb; xb.x = xa[pt].x; xb.y = xa[pt].y; xb.z = xc[pt].x; xb.w = xc[pt].y;
                    accd[pt] = __builtin_amdgcn_mfma_f32_16x16x32_bf16(am, __builtin_bit_cast(bf16x8_t, xb), accd[pt], 0, 0, 0); }
            }
#pragma unroll
            for (int kh = 0; kh < 2; ++kh) { v2u h0[2][4], h1[2][4];
#pragma unroll
              for (int k2 = 0; k2 < 2; ++k2)
#pragma unroll
                  for (int pt = 0; pt < 4; ++pt) { h0[k2][pt] = tr_read8_dyn(trb_h8, 32 * (2 * kh + k2) * SS_RX + 32 * pt); h1[k2][pt] = tr_read8_dyn(trb_h8, (32 * (2 * kh + k2) + 4) * SS_RX + 32 * pt); }
              SS_LGKM_WAIT();
#pragma unroll
              for (int k2 = 0; k2 < 2; ++k2)
#pragma unroll
                  for (int pt = 0; pt < 4; ++pt) { v4u hb; hb.x = h0[k2][pt].x; hb.y = h0[k2][pt].y; hb.z = h1[k2][pt].x; hb.w = h1[k2][pt].y;
                      acco[pt] = __builtin_amdgcn_mfma_f32_16x16x32_bf16(cf[2 * kh + k2], __builtin_bit_cast(bf16x8_t, hb), acco[pt], 0, 0, 0); } }
            { const f32x4 c4 = *(const LAS f32x4*)(cum + 16 * wq + 4 * q); float ev[4];
#pragma unroll
              for (int r = 0; r < 4; ++r) ev[r] = __expf(c4[r]);
              if (dir == 0) {
#pragma unroll
                for (int pt = 0; pt < 4; ++pt)
#pragma unroll
                  for (int r = 0; r < 4; ++r) accd[pt][r] += dsk * bf2f(*(const LAS bf16*)(lds + SS_XN + (16 * wq + 4 * q + r) * SS_RX + (16 * pt + i) * 2));
              }
#pragma unroll
              for (int pt = 0; pt < 4; ++pt)
#pragma unroll
                  for (int r = 0; r < 4; ++r) Y[(size_t)(base + 16 * wq + 4 * q + r) * 8192 + head * 64 + 16 * pt + i] = (bf16)(pk2(accd[pt][r] + ev[r] * acco[pt][r], 0.f) & 0xffffu); }
            { const float sc = __expf(tot[0]);
#pragma unroll
              for (int pt = 0; pt < 4; ++pt) Hm[pt] = Hm[pt] * sc;
#pragma unroll
              for (int kh = 0; kh < 2; ++kh) {
                  v2u b0[2], b1[2], x0[2][4], x1[2][4];
#pragma unroll
                  for (int k2 = 0; k2 < 2; ++k2) { const int kk = 2 * kh + k2;
                      b0[k2] = tr_read8_dyn(trb_b8, 32 * kk * SS_RS); b1[k2] = tr_read8_dyn(trb_b8, (32 * kk + 4) * SS_RS);
#pragma unroll
                      for (int pt = 0; pt < 4; ++pt) { x0[k2][pt] = tr_read8_dyn(trb_x8, 32 * kk * SS_RX + 32 * pt); x1[k2][pt] = tr_read8_dyn(trb_x8, (32 * kk + 4) * SS_RX + 32 * pt); } }
                  SS_LGKM_WAIT();
#pragma unroll
                  for (int k2 = 0; k2 < 2; ++k2) { v4u bb; bb.x = b0[k2].x; bb.y = b0[k2].y; bb.z = b1[k2].x; bb.w = b1[k2].y;
#pragma unroll
                      for (int pt = 0; pt < 4; ++pt) { v4u xx; xx.x = x0[k2][pt].x; xx.y = x0[k2][pt].y; xx.z = x1[k2][pt].x; xx.w = x1[k2][pt].y;
                          Hm[pt] = __builtin_amdgcn_mfma_f32_16x16x32_bf16(__builtin_bit_cast(bf16x8_t, xx), __builtin_bit_cast(bf16x8_t, bb), Hm[pt], 0, 0, 0); } } } }
            if (w == 0 && j + 1 < 66) SSD_SCAN((j + 1) & 1);
        }
#undef SSD_LOAD
#undef SSD_SCAN
        __syncthreads();
    }
}

__device__ __forceinline__ void ssd_finish_phase(const bf16* YF, const bf16* YB, const bf16* ZX, const float* norm_w, bf16* A2, int gw, int NGW, int lane) {
    f32x4 nwr[2][2]; int g_have = -1;
    for (int it = gw; it < TT * 8; it += NGW) {
        const int r = it >> 3, g = it & 7;
        if (g != g_have) { g_have = g;
#pragma unroll
            for (int j = 0; j < 2; ++j) { const int c = g * 1024 + 8 * (lane + 64 * j); nwr[j][0] = *(const f32x4*)(norm_w + c); nwr[j][1] = *(const f32x4*)(norm_w + c + 4); } }
        v4u yfp[2], ybp[2], zp[2];
#pragma unroll
        for (int j = 0; j < 2; ++j) { const int c = g * 1024 + 8 * (lane + 64 * j);
            yfp[j] = *(const v4u*)(YF + (size_t)r * 8192 + c); ybp[j] = *(const v4u*)(YB + (size_t)r * 8192 + c); zp[j] = *(const v4u*)(ZX + (size_t)r * SSD_ZXW + c); }
        float y[2][8]; float ss = 0.f;
#pragma unroll
        for (int j = 0; j < 2; ++j)
#pragma unroll
            for (int e = 0; e < 4; ++e) {
                const float v0 = (bflo(yfp[j][e]) + bflo(ybp[j][e])) * silu_f(bflo(zp[j][e])), v1 = (bfhi(yfp[j][e]) + bfhi(ybp[j][e])) * silu_f(bfhi(zp[j][e]));
                y[j][2 * e] = v0; y[j][2 * e + 1] = v1; ss += v0 * v0 + v1 * v1; }
        ss = wave_sum(ss); const float rs = rsqrtf(ss * (1.f / 1024.f) + RMS_EPS);
#pragma unroll
        for (int j = 0; j < 2; ++j) { const int c = g * 1024 + 8 * (lane + 64 * j); const f32x4 n0 = nwr[j][0], n1 = nwr[j][1];
            v4u w; w.x = pk2(y[j][0] * rs * n0.x, y[j][1] * rs * n0.y); w.y = pk2(y[j][2] * rs * n0.z, y[j][3] * rs * n0.w);
            w.z = pk2(y[j][4] * rs * n1.x, y[j][5] * rs * n1.y); w.w = pk2(y[j][6] * rs * n1.z, y[j][7] * rs * n1.w);
            *(v4u*)(A2 + (size_t)r * 8192 + c) = w; }
    }
}

constexpr int S5_POW = 0, S5_C = 17408, S5_BB = 33792, S5_A16 = 50176, S5_SCB = 51200, S5_HSB = 101376, S5_KL = 51200, S5_END = 125952;
static_assert(S5_END <= LDSCTL_OFF, "S5 LDS map");
__device__ __forceinline__ int s5_tile_of(int half, int k) { return half ? (k == 0 ? 0 : 33 - k) : k; }
__device__ __forceinline__ void s5_mixer_phase(const bf16* H, const float* lam_re, const float* lam_im, const float* log_step, const float* b_re, const float* b_im,
                                               const float* c_re, const float* c_im, const float* d_skip, bf16* HSG, bf16* A5, LAS unsigned char* lds, int tid) {
    LAS float* POW = (LAS float*)(lds + S5_POW); LAS float* CT = (LAS float*)(lds + S5_C); LAS float* BB = (LAS float*)(lds + S5_BB); LAS float* A16 = (LAS float*)(lds + S5_A16);
    LAS float* SCB = (LAS float*)(lds + S5_SCB); LAS bf16* HSB = (LAS bf16*)(lds + S5_HSB); LAS float* KL = (LAS float*)(lds + S5_KL);
    for (int g = blockIdx.x; g < 256; g += gridDim.x) {
        int tq = tid; asm volatile("" : "+v"(tq));
        const int lane = tq & 63, w = __builtin_amdgcn_readfirstlane(tq >> 6), wq = tq >> 6, i = lane & 15, q = lane >> 4;
        __syncthreads();
        if (tid < 128) { const int d = tid >> 6, p = tid & 63;
            const float step = __expf(log_step[d * 256 + g]); const float lr = lam_re[(size_t)(d * 256 + g) * 64 + p], li = lam_im[(size_t)(d * 256 + g) * 64 + p];
            const float mag = expf(lr * step), ar = mag * cosf(li * step), ai = mag * sinf(li * step);
            const float den = lr * lr + li * li, kr = ((ar - 1.f) * lr + ai * li) / den, ki = (ai * lr - (ar - 1.f) * li) / den;
            float pr = 1.f, pi = 0.f;
            for (int e = 0; e <= 16; ++e) { POW[((d * 17 + e) * 64 + p) * 2] = pr; POW[((d * 17 + e) * 64 + p) * 2 + 1] = pi; const float nr = pr * ar - pi * ai, ni = pr * ai + pi * ar; pr = nr; pi = ni; }
            A16[(d * 64 + p) * 2] = POW[((d * 17 + 16) * 64 + p) * 2]; A16[(d * 64 + p) * 2 + 1] = POW[((d * 17 + 16) * 64 + p) * 2 + 1];
            for (int c = 0; c < 16; ++c) { const float br = b_re[(size_t)(g * 64 + p) * 16 + c], bi = b_im[(size_t)(g * 64 + p) * 16 + c];
                BB[((d * 64 + p) * 16 + c) * 2] = kr * br - ki * bi; BB[((d * 64 + p) * 16 + c) * 2 + 1] = kr * bi + ki * br; } }
        for (int idx = tid; idx < 2048; idx += NWAVES * 64) { const int d = idx >> 10, c = (idx >> 6) & 15, p = idx & 63;
            CT[idx * 2] = c_re[((size_t)(d * 256 + g) * 16 + c) * 64 + p]; CT[idx * 2 + 1] = c_im[((size_t)(d * 256 + g) * 16 + c) * 64 + p]; }
        __syncthreads();
        const int half = w >> 2, reim = (w >> 1) & 1;
        {
            bf16x8_t sa[2][8];
#pragma unroll
            for (int t2 = 0; t2 < 2; ++t2) { const int p = 32 * (w & 1) + 16 * t2 + i;
#pragma unroll
                for (int kk = 0; kk < 8; ++kk) { const int sT = 2 * kk + (q >> 1), e = half ? sT : 15 - sT;
                    const float pr = POW[((half * 17 + e) * 64 + p) * 2], pi = POW[((half * 17 + e) * 64 + p) * 2 + 1];
                    float v[8];
#pragma unroll
                    for (int j = 0; j < 8; ++j) { const float br = BB[((half * 64 + p) * 16 + 8 * (q & 1) + j) * 2], bi = BB[((half * 64 + p) * 16 + 8 * (q & 1) + j) * 2 + 1]; v[j] = reim ? (pr * bi + pi * br) : (pr * br - pi * bi); }
                    v4u pk; pk.x = pk2(v[0], v[1]); pk.y = pk2(v[2], v[3]); pk.z = pk2(v[4], v[5]); pk.w = pk2(v[6], v[7]); sa[t2][kk] = __builtin_bit_cast(bf16x8_t, pk); __builtin_amdgcn_sched_barrier(0); } }
            float hr = 0.f, hi = 0.f;
#pragma unroll 1
            for (int b = 0; b < 11; ++b) {
#pragma unroll 1
                for (int sl = 0; sl < 3; ++sl) { const int nt = s5_tile_of(half, 3 * b + sl);
                    bf16x8_t ub[8];
#pragma unroll
                    for (int kk = 0; kk < 8; ++kk) ub[kk] = *(const bf16x8_t*)(H + (size_t)(256 * nt + 16 * i + 2 * kk + (q >> 1)) * DM + 16 * g + 8 * (q & 1));
#pragma unroll
                    for (int t2 = 0; t2 < 2; ++t2) { f32x4 acc = {0.f, 0.f, 0.f, 0.f};
#pragma unroll
                        for (int kk = 0; kk < 8; ++kk) acc = __builtin_amdgcn_mfma_f32_16x16x32_bf16(sa[t2][kk], ub[kk], acc, 0, 0, 0);
#pragma unroll
                        for (int r = 0; r < 4; ++r) SCB[(32 * wq + 16 * t2 + 4 * q + r) * 49 + 16 * sl + i] = acc[r]; } }
                __syncthreads();
                if (tid < 128) { const int d = tid >> 6, p = tid & 63; const float ar16 = A16[(d * 64 + p) * 2], ai16 = A16[(d * 64 + p) * 2 + 1];
                    const LAS float* sre = SCB + (d * 128 + p) * 49; const LAS float* sim = SCB + (d * 128 + 64 + p) * 49;
#pragma unroll 2
                    for (int pos = 0; pos < 48; ++pos) { const int col = d ? (16 * (pos >> 4) + 15 - (pos & 15)) : pos;
                        HSB[(d * 48 + col) * 128 + p] = (bf16)(pk2(hr, 0.f) & 0xffffu); HSB[(d * 48 + col) * 128 + 64 + p] = (bf16)(pk2(hi, 0.f) & 0xffffu);
                        const float nr = ar16 * hr - ai16 * hi + sre[col], ni = ar16 * hi + ai16 * hr + sim[col]; hr = nr; hi = ni; } }
                __syncthreads();
                for (int idx = tid; idx < 1536; idx += NWAVES * 64) { const int d = idx / 768, rem = idx % 768, col = rem >> 4, pc = rem & 15;
                    const int chunk = 16 * s5_tile_of(d, 3 * b + (col >> 4)) + (col & 15);
                    *(v4u*)(HSG + ((size_t)(g * 528 + chunk) * 256 + d * 128 + 8 * pc)) = *(const LAS v4u*)(HSB + (d * 48 + col) * 128 + 8 * pc); }
            }
        }
        asm volatile("s_waitcnt vmcnt(0)" ::: "memory");
        __syncthreads();
        { const int d = tid >> 8, lag = (tid >> 4) & 15, c = tid & 15; float acc[16];
#pragma unroll
          for (int cc = 0; cc < 16; ++cc) acc[cc] = 0.f;
          for (int p = 0; p < 64; ++p) { const float cr = CT[((d * 16 + c) * 64 + p) * 2], ci = CT[((d * 16 + c) * 64 + p) * 2 + 1], pr = POW[((d * 17 + lag) * 64 + p) * 2], pi = POW[((d * 17 + lag) * 64 + p) * 2 + 1];
              const float xr = cr * pr - ci * pi, xi = cr * pi + ci * pr;
#pragma unroll
              for (int cc = 0; cc < 16; ++cc) acc[cc] += xr * BB[((d * 64 + p) * 16 + cc) * 2] - xi * BB[((d * 64 + p) * 16 + cc) * 2 + 1]; }
#pragma unroll
          for (int cc = 0; cc < 16; ++cc) KL[((d * 16 + lag) * 16 + c) * 16 + cc] = acc[cc]; }
        __syncthreads();
        {
            bf16x8_t tf[2][8], wf[2][8];
#pragma unroll
            for (int t2 = 0; t2 < 2; ++t2) { const int l = 2 * wq + t2;
#pragma unroll
                for (int kk = 0; kk < 8; ++kk) { const int sT = 2 * kk + (q >> 1); float v[8];
#pragma unroll
                    for (int j = 0; j < 8; ++j) { const int cc = 8 * (q & 1) + j;
                        const int dl = sT - l, dsel = dl > 0 ? 1 : 0, lag = dl > 0 ? dl : -dl;
                        v[j] = KL[((dsel * 16 + lag) * 16 + i) * 16 + cc] + (dl == 0 ? KL[((16 + 0) * 16 + i) * 16 + cc] : 0.f); }
                    v4u pk; pk.x = pk2(v[0], v[1]); pk.y = pk2(v[2], v[3]); pk.z = pk2(v[4], v[5]); pk.w = pk2(v[6], v[7]); tf[t2][kk] = __builtin_bit_cast(bf16x8_t, pk); __builtin_amdgcn_sched_barrier(0); }
#pragma unroll
                for (int kk = 0; kk < 8; ++kk) { const int d = kk >> 2, ri = (kk >> 1) & 1, e = d ? 16 - l : l + 1; float v[8];
#pragma unroll
                    for (int j = 0; j < 8; ++j) { const int p = 32 * (kk & 1) + 8 * q + j;
                        const float cr = CT[((d * 16 + i) * 64 + p) * 2], ci = CT[((d * 16 + i) * 64 + p) * 2 + 1], pr = POW[((d * 17 + e) * 64 + p) * 2], pi = POW[((d * 17 + e) * 64 + p) * 2 + 1];
                        v[j] = ri ? -(cr * pi + ci * pr) : (cr * pr - ci * pi); }
                    v4u pk; pk.x = pk2(v[0], v[1]); pk.y = pk2(v[2], v[3]); pk.z = pk2(v[4], v[5]); pk.w = pk2(v[6], v[7]); wf[t2][kk] = __builtin_bit_cast(bf16x8_t, pk); __builtin_amdgcn_sched_barrier(0); } }
            const f32x4 d4 = *(const f32x4*)(d_skip + 16 * g + 4 * q);
#pragma unroll 1
            for (int nt = 0; nt < 33; ++nt) {
                bf16x8_t ub[8], hb[8];
#pragma unroll
                for (int kk = 0; kk < 8; ++kk) { ub[kk] = *(const bf16x8_t*)(H + (size_t)(256 * nt + 16 * i + 2 * kk + (q >> 1)) * DM + 16 * g + 8 * (q & 1));
                    hb[kk] = *(const bf16x8_t*)(HSG + ((size_t)(g * 528 + 16 * nt + i) * 256 + 32 * kk + 8 * q)); }
#pragma unroll
                for (int t2 = 0; t2 < 2; ++t2) { f32x4 acc = {0.f, 0.f, 0.f, 0.f};
#pragma unroll
                    for (int kk = 0; kk < 8; ++kk) { acc = __builtin_amdgcn_mfma_f32_16x16x32_bf16(tf[t2][kk], ub[kk], acc, 0, 0, 0); acc = __builtin_amdgcn_mfma_f32_16x16x32_bf16(wf[t2][kk], hb[kk], acc, 0, 0, 0); }
                    const size_t off = (size_t)(256 * nt + 16 * i + 2 * wq + t2) * DM + 16 * g + 4 * q;
                    const v2u uu = *(const v2u*)(H + off);
                    const float y0 = acc[0] + d4.x * bflo(uu.x), y1 = acc[1] + d4.y * bfhi(uu.x), y2 = acc[2] + d4.z * bflo(uu.y), y3 = acc[3] + d4.w * bfhi(uu.y);
                    v2u o; o.x = pk2(gelu_tanh_f(y0), gelu_tanh_f(y1)); o.y = pk2(gelu_tanh_f(y2), gelu_tanh_f(y3));
                    *(v2u*)(A5 + off) = o; }
            }
        }
    }
}
__device__ __forceinline__ void s5_glu_phase(const bf16* Z, const float* modL, int g_off, float* X, int gtid, int NT) {
    const size_t n4 = (size_t)TT * DM / 4;
    for (size_t i = gtid; i < n4; i += NT) { const size_t e = i * 4; const int r = (int)(e >> 12), c = (int)(e & (DM - 1));
        const v2u za = *(const v2u*)(Z + (size_t)r * 8192 + c), zg = *(const v2u*)(Z + (size_t)r * 8192 + 4096 + c);
        const f32x4 gt = *(const f32x4*)(modL + (r < TC ? MODW : 0) + g_off + c);
        f32x4 xv = *(const f32x4*)(X + e);
        xv.x += gt.x * bflo(za.x) * sigmoid_f(bflo(zg.x)); xv.y += gt.y * bfhi(za.x) * sigmoid_f(bfhi(zg.x));
        xv.z += gt.z * bflo(za.y) * sigmoid_f(bflo(zg.y)); xv.w += gt.w * bfhi(za.y) * sigmoid_f(bfhi(zg.y));
        *(f32x4*)(X + e) = xv; }
}

__device__ __forceinline__ void s5_glu_norm_phase(const bf16* __restrict__ Z, const float* __restrict__ modL, bf16* __restrict__ X, const float* __restrict__ gain, bf16* __restrict__ H, int gw, int NGW, int lane) {
    for (int r = gw; r < TT; r += NGW) {
        bf16* xr = X + (size_t)r * DM; const bf16* zr = Z + (size_t)r * 8192; const float* md = modL + (r < TC ? MODW : 0);
        f32x4 v[8][2]; float ss = 0.f;
#pragma unroll
        for (int j = 0; j < 8; ++j) { const int c = 8 * (lane + 64 * j);
            const v4u xb = *(const v4u*)(xr + c), za = *(const v4u*)(zr + c), zg = *(const v4u*)(zr + 4096 + c);
            v4u xo;
#pragma unroll
            for (int h = 0; h < 2; ++h) { const f32x4 gt = *(const f32x4*)(md + 8192 + c + 4 * h); const unsigned x0 = xb[2 * h], x1 = xb[2 * h + 1], a0 = za[2 * h], a1 = za[2 * h + 1], g0 = zg[2 * h], g1 = zg[2 * h + 1];
                f32x4 o; o.x = bflo(x0) + gt.x * bflo(a0) * sigmoid_f(bflo(g0)); o.y = bfhi(x0) + gt.y * bfhi(a0) * sigmoid_f(bfhi(g0));
                o.z = bflo(x1) + gt.z * bflo(a1) * sigmoid_f(bflo(g1)); o.w = bfhi(x1) + gt.w * bfhi(a1) * sigmoid_f(bfhi(g1));
                v[j][h] = o; ss += (o.x * o.x + o.y * o.y) + (o.z * o.z + o.w * o.w); xo[2 * h] = pk2(o.x, o.y); xo[2 * h + 1] = pk2(o.z, o.w); }
            *(v4u*)(xr + c) = xo; }
        ss = wave_sum(ss); const float rs = rsqrtf(ss * (1.f / DM) + RMS_EPS);
#pragma unroll
        for (int j = 0; j < 8; ++j) { const int c = 8 * (lane + 64 * j);
            f32x4 o[2];
#pragma unroll
            for (int h = 0; h < 2; ++h) { const f32x4 g = *(const f32x4*)(gain + c + 4 * h), sc = *(const f32x4*)(md + 16384 + c + 4 * h), sh = *(const f32x4*)(md + 12288 + c + 4 * h);
                o[h] = (v[j][h] * rs) * g * (sc + 1.f) + sh; }
            v4u w; w.x = pk2(o[0].x, o[0].y); w.y = pk2(o[0].z, o[0].w); w.z = pk2(o[1].x, o[1].y); w.w = pk2(o[1].z, o[1].w); *(v4u*)(H + (size_t)r * DM + c) = w; }
    }
}

__device__ __forceinline__ void da_qknorm_phase(bf16* QKV, const float* q_gain, const float* k_gain, const float* ROPE, unsigned* kmax_bits, int gw, int NGW, int lane) {
    float kmx = 0.f;
    const int k16 = lane & 15, half = k16 >> 3, kk = k16 & 7, el = 8 * k16;
    const bool first = kk < 4;
    constexpr int QU = 6;
    f32x4 g0 = {0.f, 0.f, 0.f, 0.f}, g1 = {0.f, 0.f, 0.f, 0.f}; int hq_have = -1;
    for (int it0 = gw; it0 < TT * 16; it0 += QU * NGW) {
        v4u rawq[QU];
#pragma unroll
        for (int u = 0; u < QU; ++u) { const int it = it0 + u * NGW; rawq[u] = (it < TT * 16) ? *(const v4u*)(QKV + (size_t)(it >> 4) * 12288 + (4 * (it & 15) + (lane >> 4)) * 128 + el) : (v4u){0u, 0u, 0u, 0u}; }
        asm volatile("" ::: "memory");
#pragma unroll
        for (int u = 0; u < QU; ++u) { const int it = it0 + u * NGW; if (it >= TT * 16) break;
        const int r = it >> 4, hq = it & 15; const int hh = 4 * hq + (lane >> 4);
        bf16* px = QKV + (size_t)r * 12288 + hh * 128 + el;
        const v4u raw = rawq[u];
        float x[8];
#pragma unroll
        for (int e = 0; e < 4; ++e) { x[2 * e] = bflo(raw[e]); x[2 * e + 1] = bfhi(raw[e]); }
        float ss = 0.f;
#pragma unroll
        for (int e = 0; e < 8; ++e) ss += x[e] * x[e];
        ss += __shfl_xor(ss, 1); ss += __shfl_xor(ss, 2); ss += __shfl_xor(ss, 4); ss += __shfl_xor(ss, 8);
        const float rs = rsqrtf(ss * (1.f / 128.f) + RMS_EPS);
        if (hq != hq_have) { hq_have = hq; const float* gn = (hh < 32 ? q_gain : k_gain) + el; g0 = *(const f32x4*)gn; g1 = *(const f32x4*)(gn + 4); }
        float y[8];
        y[0] = x[0] * rs * g0.x; y[1] = x[1] * rs * g0.y; y[2] = x[2] * rs * g0.z; y[3] = x[3] * rs * g0.w; y[4] = x[4] * rs * g1.x; y[5] = x[5] * rs * g1.y; y[6] = x[6] * rs * g1.z; y[7] = x[7] * rs * g1.w;
        float pv[8];
#pragma unroll
        for (int e = 0; e < 8; ++e) pv[e] = __shfl_xor(y[e], 4);
        if (r >= TC) { const int t = r - TC; const int pos = half ? (t & 63) : (t >> 6);
            const float* cs = ROPE + ((size_t)pos * 32 + 8 * (kk & 3)) * 2;
#pragma unroll
            for (int e = 0; e < 4; ++e) { const f32x4 c2 = *(const f32x4*)(cs + 4 * e);
                const float a0 = y[2 * e], a1 = y[2 * e + 1], b0 = pv[2 * e], b1 = pv[2 * e + 1];
                y[2 * e] = first ? (a0 * c2.x - b0 * c2.y) : (b0 * c2.y + a0 * c2.x);
                y[2 * e + 1] = first ? (a1 * c2.z - b1 * c2.w) : (b1 * c2.w + a1 * c2.z); } }
        v4u o; o.x = pk2(y[0], y[1]); o.y = pk2(y[2], y[3]); o.z = pk2(y[4], y[5]); o.w = pk2(y[6], y[7]);
        *(v4u*)px = o;
        { float s2 = 0.f;
#pragma unroll
          for (int e = 0; e < 8; ++e) s2 += y[e] * y[e];
          s2 += __shfl_xor(s2, 1); s2 += __shfl_xor(s2, 2); s2 += __shfl_xor(s2, 4); s2 += __shfl_xor(s2, 8); kmx = fmaxf(kmx, s2); }
    }
    }
    if ((NGW & 15) == 0) { const int hh = 4 * (gw & 15) + (lane >> 4); if (hh >= 32 && (lane & 15) == 0 && gw < TT * 16) atomicMax(kmax_bits + (hh - 32), __float_as_uint(kmx)); }
}
__device__ __forceinline__ void da_combine_phase(const float* O, const float* lq1, const float* lk1, const float* lq2, const float* lk2, const float* sub_gain, float lambda_init, bf16* AO, int gw, int NGW, int lane) {
    const float s1 = wave_sum(lq1[lane] * lk1[lane] + lq1[lane + 64] * lk1[lane + 64]), s2 = wave_sum(lq2[lane] * lk2[lane] + lq2[lane + 64] * lk2[lane + 64]);
    const float lam = expf(s1) - expf(s2) + lambda_init;
    const f32x4 sg = *(const f32x4*)(sub_gain + 4 * lane);
    constexpr int CU_ = 6;
    for (int it0 = gw; it0 < TT * 16; it0 += CU_ * NGW) {
        f32x4 a1[CU_], a2[CU_];
#pragma unroll
        for (int u = 0; u < CU_; ++u) { const int it = it0 + u * NGW; const bool ok = it < TT * 16; const float* po = O + (size_t)(it >> 4) * 8192 + (it & 15) * 256 + 4 * lane;
            a1[u] = ok ? *(const f32x4*)po : (f32x4){0.f, 0.f, 0.f, 0.f}; a2[u] = ok ? *(const f32x4*)(po + 4096) : (f32x4){0.f, 0.f, 0.f, 0.f}; }
        asm volatile("" ::: "memory");
#pragma unroll
        for (int u = 0; u < CU_; ++u) { const int it = it0 + u * NGW; if (it >= TT * 16) break;
            const int r = it >> 4, hd = it & 15;
            const f32x4 o = a1[u] - a2[u] * lam;
            const float ss = wave_sum((o.x * o.x + o.y * o.y) + (o.z * o.z + o.w * o.w)); const float rs = rsqrtf(ss * (1.f / 256.f) + RMS_EPS) * (1.f - lambda_init);
            const f32x4 w = o * rs * sg; v2u pk; pk.x = pk2(w.x, w.y); pk.y = pk2(w.z, w.w);
            *(v2u*)(AO + (size_t)r * 4096 + hd * 256 + 4 * lane) = pk; }
    }
}

struct CtxStore { bf16* O; int ldc; const float* bias;
    __device__ __forceinline__ void operator()(int row, int col, f32x4 lo, f32x4 hi) const {
        if (bias) { lo = lo + *(const f32x4*)(bias + col); hi = hi + *(const f32x4*)(bias + col + 4); }
        v4u w; w.x = pk2(lo.x, lo.y); w.y = pk2(lo.z, lo.w); w.z = pk2(hi.x, hi.y); w.w = pk2(hi.z, hi.w); *(v4u*)(O + (size_t)row * ldc + col) = w; } };
struct CtxResid { bf16* X; const float* gate; const float* Xrd;
    __device__ __forceinline__ void operator()(int row, int col, f32x4 lo, f32x4 hi) const {
        bf16* p = X + (size_t)row * 4096 + col; const f32x4 g0 = *(const f32x4*)(gate + col), g1 = *(const f32x4*)(gate + col + 4);
        f32x4 x0, x1;
        if (Xrd) { const float* pr = Xrd + (size_t)row * 4096 + col; x0 = *(const f32x4*)pr; x1 = *(const f32x4*)(pr + 4); }
        else { const v4u xb = *(const v4u*)p; x0 = f32x4{bflo(xb.x), bfhi(xb.x), bflo(xb.y), bfhi(xb.y)}; x1 = f32x4{bflo(xb.z), bfhi(xb.z), bflo(xb.w), bfhi(xb.w)}; }
        const f32x4 o0 = x0 + g0 * lo, o1 = x1 + g1 * hi;
        v4u w; w.x = pk2(o0.x, o0.y); w.y = pk2(o0.z, o0.w); w.z = pk2(o1.x, o1.y); w.w = pk2(o1.z, o1.w); *(v4u*)p = w; } };
template <class CE>
__device__ __forceinline__ void ctx_gemm(const bf16* A, const bf16* Bt, int N, int K, const CE& E, LAS unsigned char* lds, int tid, int vcu, int G) {
    int tq = tid; asm volatile("" : "+v"(tq));
    const int lane = tq & 63, wq = tq >> 6, i = lane & 15, q = lane >> 4;
    const int ksl = K >> 3;
    LAS float* RED = (LAS float*)lds;
    for (int t = vcu; t < 4 * (N >> 6); t += G) {
        const int rb = t & 3, nb = t >> 2;
        f32x4 acc[4][4];
#pragma unroll
        for (int m = 0; m < 4; ++m)
#pragma unroll
            for (int n = 0; n < 4; ++n) acc[m][n] = (f32x4){0.f, 0.f, 0.f, 0.f};
        const bf16* Ap = A + (size_t)(64 * rb + i) * K + wq * ksl + 8 * q;
        const bf16* Bp = Bt + (size_t)(64 * nb + i) * K + wq * ksl + 8 * q;
        bf16x8_t fa0[2][4], fb0[2][4], fa1[2][4], fb1[2][4];
#define CG_LOAD(FA, FB, ks0) do { _Pragma("unroll") for (int s2 = 0; s2 < 2; ++s2) _Pragma("unroll") for (int m = 0; m < 4; ++m) { \
            FA[s2][m] = *(const bf16x8_t*)(Ap + (size_t)(16 * m) * K + 32 * ((ks0) + s2)); FB[s2][m] = *(const bf16x8_t*)(Bp + (size_t)(16 * m) * K + 32 * ((ks0) + s2)); } } while (0)
#define CG_MMA(FA, FB) do { _Pragma("unroll") for (int s2 = 0; s2 < 2; ++s2) _Pragma("unroll") for (int m = 0; m < 4; ++m) _Pragma("unroll") for (int n = 0; n < 4; ++n) \
            acc[m][n] = __builtin_amdgcn_mfma_f32_16x16x32_bf16(FB[s2][n], FA[s2][m], acc[m][n], 0, 0, 0); } while (0)
        const int npair = ksl >> 6;
        CG_LOAD(fa0, fb0, 0);
        for (int pr = 0; pr < npair; pr += 2) {
            CG_LOAD(fa1, fb1, 2 * (pr + 1));
            __builtin_amdgcn_sched_barrier(0);
            CG_MMA(fa0, fb0);
            __builtin_amdgcn_sched_barrier(0);
            if (pr + 2 < npair) CG_LOAD(fa0, fb0, 2 * (pr + 2));
            __builtin_amdgcn_sched_barrier(0);
            CG_MMA(fa1, fb1);
            __builtin_amdgcn_sched_barrier(0);
        }
#undef CG_LOAD
#undef CG_MMA
#pragma unroll
        for (int m = 0; m < 4; ++m)
#pragma unroll
            for (int n = 0; n < 4; ++n) *(LAS f32x4*)(RED + (wq * 64 + 16 * m + i) * 68 + 16 * n + 4 * q) = acc[m][n];
        __syncthreads();
        { const int row = tid >> 3, c8 = (tid & 7) * 8; f32x4 lo = {0.f, 0.f, 0.f, 0.f}, hi = {0.f, 0.f, 0.f, 0.f};
#pragma unroll
          for (int w8 = 0; w8 < 8; ++w8) { lo = lo + *(const LAS f32x4*)(RED + (w8 * 64 + row) * 68 + c8); hi = hi + *(const LAS f32x4*)(RED + (w8 * 64 + row) * 68 + c8 + 4); }
          E(64 * rb + row, 64 * nb + c8, lo, hi); }
        __syncthreads();
    }
}

struct Args { const float* in[41]; float* out; unsigned char* ws; int ph_lo, ph_hi; };
static_assert(sizeof(Args) == 41 * 8 + 8 + 8 + 8, "Args has no padding");
struct KC {
    LAS unsigned char* lds; char* lds_gen; unsigned char* ws; float* out;
    int tid, lane, wave, G, bx, vcu, gw, NGW, gtid, NT, lo, hi, ph;
    XcdBarrier bar;
};
#ifndef PROBE_REP
#define PROBE_REP 1
#endif
#ifndef PROBE_ATT
#define PROBE_ATT 1
#endif
#if PROBE_REP == 2
#define REP2(x) do { x; __syncthreads(); x; } while (0)
#else
#define REP2(x) do { x; } while (0)
#endif
#define PH_ON (K.ph >= K.lo && K.ph < K.hi)
#define SEAM() do { if (K.ph >= K.lo && K.ph + 1 < K.hi) xcd_barrier(K.bar); ++K.ph; } while (0)
#define WSP(T, off) ((T*)(K.ws + (off)))

template <int LAYER> __device__ __forceinline__ void run_layer(KC& K, const Args& args) {
    constexpr int kind = LAYER % 3, jl = LAYER / 3;
    const float* modL = WSP(float, WS_MOD) + (size_t)LAYER * 2 * MODW;
    if (PH_ON) REP2(norm_mod_phase(WSP(bf16, WS_X), args.in[6] + (size_t)LAYER * DM, modL, 0, 4096, WSP(bf16, WS_H), K.gw, K.NGW, K.lane, LAYER == 0 ? args.in[2] : nullptr, LAYER == 0 ? args.in[0] : nullptr));
    SEAM();
    if constexpr (kind == 0) {
        if (PH_ON) { pg8::Gemm g{WSP(bf16, WS_H), WSP(bf16, WS_WSI) + (size_t)jl * SSD_INC * 4096, TT, SSD_INC, 4096}; pg8::StaticOrder S; S.init(TT, SSD_INC, K.G, K.bx);
            pg8::EpiStore E{WSP(bf16, WS_BIG), SSD_ZXW, nullptr, 72, WSP(float, WS_DT), args.in[16] + (size_t)jl * 256, 0};
            pg8::gemm_phase<pg8::EpiStore, pg8::StaticOrder, true, true>(K.lds, g, S, E);
            { const int first = ((TT / 256) * (SSD_INC / 256)) % K.G;
              if (first == 0 || K.bx >= first) {
                  __syncthreads();
                  LAS float* scr = (LAS float*)(K.lds + K.wave * 16384);
                  const int gwt = (K.bx - first) * NWAVES + K.wave, ngwt = (K.G - first) * NWAVES;
                  if constexpr (LAYER == 0) {
                      transpose_matrix(args.in[30], 4096, 4096, WSP(bf16, WS_WQKV), 0, scr, gwt, ngwt, K.lane);
                      transpose_matrix(args.in[31], 4096, 4096, WSP(bf16, WS_WQKV), 4096, scr, gwt, ngwt, K.lane);
                      transpose_matrix(args.in[32], 4096, 4096, WSP(bf16, WS_WQKV), 8192, scr, gwt, ngwt, K.lane);
                      transpose_matrix(args.in[33], 4096, 4096, WSP(bf16, WS_WO), 0, scr, gwt, ngwt, K.lane);
                  } else {
                      transpose_matrix(args.in[8] + (size_t)LAYER * 4096 * 8192, 4096, 8192, WSP(bf16, WS_WUP) + (size_t)LAYER * 8192 * 4096, 0, scr, gwt, ngwt, K.lane);
                      transpose_matrix(args.in[11] + (size_t)LAYER * 4096 * 4096, 4096, 4096, WSP(bf16, WS_WDN) + (size_t)LAYER * 4096 * 4096, 0, scr, gwt, ngwt, K.lane);
                  }
              } } }
        SEAM();
        if (PH_ON) REP2(ssd_conv_phase(WSP(bf16, WS_BIG), args.in[13] + (size_t)jl * 5 * SSD_CC, args.in[14] + (size_t)jl * SSD_CC, WSP(bf16, WS_XBC), K.gw, K.NGW, K.lane));
        SEAM();
        if (PH_ON) REP2(ssd_scan_phase(WSP(bf16, WS_XBC), WSP(float, WS_DT), args.in[15] + (size_t)jl * 256, args.in[17] + (size_t)jl * 128, WSP(bf16, WS_Y0), WSP(bf16, WS_Y1), K.lds, K.tid));
        SEAM();
        if (PH_ON) REP2(ssd_finish_phase(WSP(bf16, WS_Y0), WSP(bf16, WS_Y1), WSP(bf16, WS_BIG), args.in[18] + (size_t)jl * 8192, WSP(bf16, WS_A2), K.gw, K.NGW, K.lane));
        SEAM();
        if (PH_ON) { const bf16* Wt = WSP(bf16, WS_WSO) + (size_t)jl * 4096 * 8192;
            pg8::Gemm g{WSP(bf16, WS_A2) + (size_t)TC * 8192, Wt, TL, 4096, 8192}; pg8::StaticOrder S; S.init(TL, 4096, K.G, K.bx);
            pg8::EpiResid E{WSP(bf16, WS_X), modL + 8192, modL + MODW + 8192, nullptr, TC, LAYER == 0 ? args.in[0] - (size_t)TC * DM : nullptr};
            pg8::gemm_phase<pg8::EpiResid, pg8::StaticOrder, true, true>(K.lds, g, S, E);
            if (LAYER < DEPTH - 1) ctx_gemm(WSP(bf16, WS_A2), Wt, 4096, 8192, CtxResid{WSP(bf16, WS_X), modL + MODW + 8192, LAYER == 0 ? args.in[2] : nullptr}, K.lds, K.tid, K.vcu, K.G); }
        SEAM();
    } else if constexpr (kind == 1) {
        if (PH_ON) REP2(s5_mixer_phase(WSP(bf16, WS_H), args.in[20], args.in[21], args.in[22], args.in[23], args.in[24], args.in[25], args.in[26], args.in[27], WSP(bf16, WS_Y0), WSP(bf16, WS_A2), K.lds, K.tid));
        SEAM();
        if (PH_ON) { pg8::Gemm g{WSP(bf16, WS_A2) + (size_t)TC * 4096, WSP(bf16, WS_WGL), TL, 8192, 4096}; pg8::StaticOrder S; S.init(TL, 8192, K.G, K.bx);
            pg8::EpiStore E{WSP(bf16, WS_BIG), 8192, args.in[29], -1, nullptr, nullptr, TC};
            pg8::gemm_phase<pg8::EpiStore, pg8::StaticOrder, true, true>(K.lds, g, S, E);
            ctx_gemm(WSP(bf16, WS_A2), WSP(bf16, WS_WGL), 8192, 4096, CtxStore{WSP(bf16, WS_BIG), 8192, args.in[29]}, K.lds, K.tid, K.vcu, K.G); }
        SEAM();
        if (PH_ON) s5_glu_norm_phase(WSP(bf16, WS_BIG), modL, WSP(bf16, WS_X), args.in[7] + (size_t)LAYER * DM, WSP(bf16, WS_H), K.gw, K.NGW, K.lane);
        SEAM();
    } else {
        if (PH_ON) { pg8::Gemm g{WSP(bf16, WS_H) + (size_t)TC * 4096, WSP(bf16, WS_WQKV), TL, 12288, 4096}; pg8::StaticOrder S; S.init(TL, 12288, K.G, K.bx);
            pg8::EpiStore E{WSP(bf16, WS_BIG), 12288, nullptr, -1, nullptr, nullptr, TC};
            pg8::gemm_phase<pg8::EpiStore, pg8::StaticOrder, true, true>(K.lds, g, S, E);
            ctx_gemm(WSP(bf16, WS_H), WSP(bf16, WS_WQKV), 12288, 4096, CtxStore{WSP(bf16, WS_BIG), 12288, nullptr}, K.lds, K.tid, K.vcu, K.G); }
        SEAM();
        if (PH_ON) da_qknorm_phase(WSP(bf16, WS_BIG), args.in[34], args.in[35], WSP(float, WS_ROPE), WSP(unsigned, WS_CTL) + CW_KMAX, K.gw, K.NGW, K.lane);
        SEAM();
        if (PH_ON) {
            const float* lq1 = args.in[36]; const float* lk1 = args.in[37]; const float* lq2 = args.in[38]; const float* lk2 = args.in[39];
            const float lambda_init = 0.8f - 0.6f * expf(-0.3f * (float)LAYER);
            const float s1 = wave_sum(lq1[K.lane] * lk1[K.lane] + lq1[K.lane + 64] * lk1[K.lane + 64]), s2 = wave_sum(lq2[K.lane] * lk2[K.lane] + lq2[K.lane + 64] * lk2[K.lane + 64]);
            const float lam = expf(s1) - expf(s2) + lambda_init;
            const int nlp = (1024 + K.G - 1) / K.G, ncp = (32 + K.G - 1) / K.G;
            if (K.tid == 0) { char* pr = K.lds_gen + att2::L_PRM; *(float*)pr = lam; *(float*)(pr + 4) = 1.f - lambda_init; *(const float**)(pr + 8) = args.in[40];
                              *(float**)(pr + 16) = WSP(float, WS_Y0); *(bf16**)(pr + 24) = WSP(bf16, WS_A2); }
            __syncthreads();
            for (int i = 0; i < 2 * (nlp + ncp); ++i) {
                const int ip = i >> 1;
                int h16, qrow, seq;
                if (ip < nlp) { const int v = ip * K.G + K.vcu; if (v >= 1024) continue; h16 = v >> 6; qrow = TC + 128 * (v & 63); seq = TT; }
                else { const int v = (ip - nlp) * K.G + K.vcu; if (v >= 32) continue; h16 = v >> 1; qrow = 128 * (v & 1); seq = TC; }
                const int h32 = 2 * h16 + (i & 1);
                const bf16* QKV = WSP(bf16, WS_BIG);
                const float kmax2 = __uint_as_float(__hip_atomic_load(WSP(unsigned, WS_CTL) + CW_KMAX + h32, __ATOMIC_RELAXED, __HIP_MEMORY_SCOPE_AGENT));
                att2::attn_unit(QKV + (size_t)qrow * 12288 + h32 * 128, QKV + 4096 + h32 * 128, QKV + 8192 + h16 * 256,
                                WSP(float, WS_Y0) + (size_t)qrow * 8192 + h16 * 256, seq, kmax2, K.lds_gen, i & 1);
            }
        }
        SEAM();
        if (PH_ON) { pg8::Gemm g{WSP(bf16, WS_A2) + (size_t)TC * 4096, WSP(bf16, WS_WO), TL, 4096, 4096}; pg8::StaticOrder S; S.init(TL, 4096, K.G, K.bx);
            pg8::EpiResid E{WSP(bf16, WS_X), modL + 8192, modL + MODW + 8192, nullptr, TC};
            pg8::gemm_phase<pg8::EpiResid, pg8::StaticOrder, true, true>(K.lds, g, S, E);
            ctx_gemm(WSP(bf16, WS_A2), WSP(bf16, WS_WO), 4096, 4096, CtxResid{WSP(bf16, WS_X), modL + MODW + 8192, nullptr}, K.lds, K.tid, K.vcu, K.G); }
        SEAM();
    }
    if constexpr (kind != 1) {
    if (PH_ON) REP2(norm_mod_phase(WSP(bf16, WS_X), args.in[7] + (size_t)LAYER * DM, modL, 12288, 16384, WSP(bf16, WS_H), K.gw, K.NGW, K.lane));
    SEAM();
    }
    if (PH_ON) { const bf16* Wt = WSP(bf16, WS_WUP) + (size_t)LAYER * 8192 * 4096;
        pg8::Gemm g{WSP(bf16, WS_H) + (size_t)TC * 4096, Wt, TL, 8192, 4096}; pg8::StaticOrder S; S.init(TL, 8192, K.G, K.bx);
        pg8::EpiStore E{WSP(bf16, WS_BIG), 8192, nullptr, -1, nullptr, nullptr, TC};
        pg8::gemm_phase<pg8::EpiStore, pg8::StaticOrder, true, true>(K.lds, g, S, E);
        if (LAYER < DEPTH - 1) ctx_gemm(WSP(bf16, WS_H), Wt, 8192, 4096, CtxStore{WSP(bf16, WS_BIG), 8192, nullptr}, K.lds, K.tid, K.vcu, K.G); }
    SEAM();
    if (PH_ON) REP2(ffn_conv_phase(WSP(bf16, WS_BIG), args.in[9] + (size_t)LAYER * 3 * 8192, args.in[10] + (size_t)LAYER * 8192, WSP(bf16, WS_A2), K.gw, K.NGW, K.lane));
    SEAM();
    if (PH_ON) { const bf16* Wt = WSP(bf16, WS_WDN) + (size_t)LAYER * 4096 * 4096;
        pg8::Gemm g{WSP(bf16, WS_A2) + (size_t)TC * 4096, Wt, TL, 4096, 4096}; pg8::StaticOrder S; S.init(TL, 4096, K.G, K.bx);
        pg8::EpiResid E{WSP(bf16, WS_X), modL + 20480, modL + MODW + 20480, LAYER == DEPTH - 1 ? K.out : nullptr, TC};
        pg8::gemm_phase<pg8::EpiResid, pg8::StaticOrder, true, true>(K.lds, g, S, E);
        if (LAYER < DEPTH - 1) ctx_gemm(WSP(bf16, WS_A2), Wt, 4096, 4096, CtxResid{WSP(bf16, WS_X), modL + MODW + 20480, nullptr}, K.lds, K.tid, K.vcu, K.G); }
    SEAM();
}

__global__ void __launch_bounds__(NWAVES * 64, 2) hybrid_fwd(Args args) {
    extern __shared__ __attribute__((aligned(16))) unsigned char lds_raw[];
    KC K;
    K.lds = (LAS unsigned char*)lds_raw; K.lds_gen = (char*)lds_raw; K.ws = args.ws; K.out = args.out;
    K.tid = threadIdx.x; K.lane = K.tid & 63; K.wave = __builtin_amdgcn_readfirstlane(K.tid >> 6);
    K.G = gridDim.x; K.bx = blockIdx.x;
    K.vcu = (K.G % 8 == 0) ? (K.bx % 8) * (K.G / 8) + K.bx / 8 : K.bx;
    K.gw = K.vcu * NWAVES + K.wave; K.NGW = K.G * NWAVES; K.gtid = K.bx * NWAVES * 64 + K.tid; K.NT = K.G * NWAVES * 64;
    unsigned* ctl = (unsigned*)(K.ws + WS_CTL);
    for (int u = K.tid; u < (LDS_BYTES - LDSCTL_OFF) / 4; u += NWAVES * 64) ((LAS unsigned*)(K.lds + LDSCTL_OFF))[u] = 0u;
    __syncthreads();
    volatile LAS unsigned* MISC = (volatile LAS unsigned*)(K.lds + MISC_OFF);
    K.bar = xcd_barrier_post(ctl + CW_BAR, MISC + 8);
    K.lo = args.ph_lo; K.hi = args.ph_hi; K.ph = 0;

    if (PH_ON) {
        LAS float* scr = (LAS float*)(K.lds + K.wave * 16384);
        const int gw = K.gw, NGW = K.NGW, lane = K.lane;
        for (int l = 0; l < DEPTH - 1; ++l) transpose_matrix(args.in[8] + (size_t)l * 4096 * 8192, 4096, 8192, WSP(bf16, WS_WUP) + (size_t)l * 8192 * 4096, 0, scr, gw, NGW, lane);
        for (int l = 0; l < DEPTH - 1; ++l) transpose_matrix(args.in[11] + (size_t)l * 4096 * 4096, 4096, 4096, WSP(bf16, WS_WDN) + (size_t)l * 4096 * 4096, 0, scr, gw, NGW, lane);
        for (int l = 0; l < 2; ++l) transpose_matrix(args.in[12] + (size_t)l * 4096 * SSD_INC, 4096, SSD_INC, WSP(bf16, WS_WSI) + (size_t)l * SSD_INC * 4096, 0, scr, gw, NGW, lane);
        for (int l = 0; l < 2; ++l) transpose_matrix(args.in[19] + (size_t)l * 8192 * 4096, 8192, 4096, WSP(bf16, WS_WSO) + (size_t)l * 4096 * 8192, 0, scr, gw, NGW, lane);
        transpose_matrix(args.in[28], 4096, 8192, WSP(bf16, WS_WGL), 0, scr, gw, NGW, lane);
        { float* ROPE = WSP(float, WS_ROPE);
          for (int i = K.gtid; i < 128 * 32; i += K.NT) { const int pos = i >> 5, f = i & 31; const float inv = powf(10000.f, -(float)f / 32.f); const float ang = (float)pos * inv;
            ROPE[2 * i] = cosf(ang); ROPE[2 * i + 1] = sinf(ang); } }
        __syncthreads();
        mod_phase(args.in[1], args.in[3], args.in[4], args.in[5], WSP(float, WS_MOD), K.lds, K.tid, K.wave, K.lane);
    }
    SEAM();
    run_layer<0>(K, args);
    run_layer<1>(K, args);
    run_layer<2>(K, args);
    run_layer<3>(K, args);
}
#undef PH_ON
#undef SEAM
#undef WSP

extern "C" void kernel_launch(void* const* d_in, const int* in_sizes, int n_in, void* d_out, int out_size, void* d_ws, size_t ws_size, hipStream_t stream) {
    static int grid = 0;
    if (grid == 0) {
        if (n_in != 41 || out_size != TL * DM || ws_size < WS_END) { fprintf(stderr, "kernel_launch: unexpected shapes: n_in %d out %d ws %zu (need %zu)\n", n_in, out_size, ws_size, (size_t)WS_END); grid = -1; return; }
        int dev = 0, cus = 0, per_cu = 0;
        if (hipGetDevice(&dev) != hipSuccess || hipDeviceGetAttribute(&cus, hipDeviceAttributeMultiprocessorCount, dev) != hipSuccess) { grid = -1; return; }
        if (hipFuncSetAttribute((const void*)hybrid_fwd, hipFuncAttributeMaxDynamicSharedMemorySize, LDS_BYTES) != hipSuccess) { fprintf(stderr, "kernel_launch: hipFuncSetAttribute failed\n"); grid = -1; return; }
        if (hipOccupancyMaxActiveBlocksPerMultiprocessor(&per_cu, (const void*)hybrid_fwd, NWAVES * 64, LDS_BYTES) != hipSuccess || per_cu < 1) { fprintf(stderr, "kernel_launch: occupancy query says %d\n", per_cu); }
        (void)hipGetLastError();
        grid = cus;
    }
    if (grid < 0) return;
    if (hipMemsetAsync((char*)d_ws + WS_CTL, 0, CTL_BYTES, stream) != hipSuccess) return;
    Args a{};
    for (int i = 0; i < 41; ++i) a.in[i] = (const float*)d_in[i];
    a.out = (float*)d_out; a.ws = (unsigned char*)d_ws; a.ph_lo = 0; a.ph_hi = 1000;
    hipLaunchKernelGGL(hybrid_fwd, dim3(grid), dim3(NWAVES * 64), LDS_BYTES, stream, a);
    const hipError_t le = hipPeekAtLastError();
    if (le != hipSuccess) fprintf(stderr, "kernel_launch: launch failed: %s\n", hipGetErrorName(le));
}
```
